# Optimizing an MI355X kernel written in HIP

```python
import math
import jax, jax.numpy as jnp
from jax import lax
import numpy as np

D_MODEL = 2048
BATCH = 1
SEQ = 16384
DEPTH = 1
DEC_BATCH = 2
DEC_SEQ = 8192
PAST_LEN = 128

D_MIX = D_MODEL
D_HYENA = D_MIX // 2
D_FNET = D_MIX - D_HYENA
HYENA_HEADS = 8
HYENA_HEAD_DIM = D_HYENA // HYENA_HEADS
FNET_GROUPS = 4
FNET_GROUP_DIM = D_FNET // FNET_GROUPS
HYENA_ORDER = 2
N_DIR = 2
SHORT_CONV = 3
FILTER_EMB = 33
FILTER_HIDDEN = 64
DECAY_TARGET = 1e-2
FAST_DECAY_PCT = 0.3
SLOW_DECAY_PCT = 1.5
MIN_DECAY = math.log(DECAY_TARGET) / SLOW_DECAY_PCT
MAX_DECAY = math.log(DECAY_TARGET) / FAST_DECAY_PCT
EPS = 1e-6
D_PROJ = 3 * D_HYENA + D_HYENA + D_FNET + D_FNET

kernel_name = "hymba_hyena_fnet_bidir_encoder"


def rmsnorm(x, g):
    xf = x.astype(jnp.float32)
    y = xf * lax.rsqrt(jnp.mean(xf * xf, axis=-1, keepdims=True) + EPS)
    return y.astype(x.dtype) * g


def positional_features(L):
    bands = (FILTER_EMB - 1) // 2
    t = jnp.linspace(0.0, 1.0, L, dtype=jnp.float32)
    w = 2.0 * math.pi * jnp.arange(L, dtype=jnp.float32) / L
    f = jnp.linspace(1e-4, bands - 1, bands, dtype=jnp.float32)
    fw = w[:, None] * f[None, :]
    return jnp.concatenate([t[:, None], jnp.cos(fw), -jnp.sin(fw)], axis=-1)


def hyena_filters(L, w1, b1, w2, b2, w3, b3, w4, freq, dtype):
    z = positional_features(L).astype(dtype)
    h = jnp.sin(freq * (z @ w1 + b1))
    h = jnp.sin(freq * (h @ w2 + b2))
    h = jnp.sin(freq * (h @ w3 + b3))
    h = (h @ w4).astype(jnp.float32).reshape(L, HYENA_ORDER, N_DIR, D_HYENA)
    t = jnp.linspace(0.0, 1.0, L, dtype=jnp.float32)[:, None]
    deltas = jnp.tile(jnp.linspace(MIN_DECAY, MAX_DECAY, HYENA_HEAD_DIM, dtype=jnp.float32), HYENA_HEADS)
    decay = jnp.exp(-t * jnp.abs(deltas)[None, :])
    return h * decay[:, None, None, :]


def bidir_long_conv(v, h_fwd, h_bwd, skip):
    L = v.shape[1]
    n = 2 * L
    k = jnp.concatenate([h_fwd, jnp.zeros((1, h_fwd.shape[1]), jnp.float32), h_bwd[:0:-1]], axis=0)
    k_f = jnp.fft.rfft(k, n=n, axis=0)
    vf = v.astype(jnp.float32)
    v_f = jnp.fft.rfft(vf, n=n, axis=1)
    y = jnp.fft.irfft(v_f * k_f[None], n=n, axis=1)[:, :L]
    return (y + vf * skip.astype(jnp.float32)).astype(v.dtype)


def centred_short_conv(u, w, b):
    L = u.shape[1]
    up = jnp.pad(u, ((0, 0), (1, 1), (0, 0)))
    return up[:, :L] * w[0] + up[:, 1:L + 1] * w[1] + up[:, 2:] * w[2] + b


def mixer_layer(x, norm_g, w_in, conv_w, conv_b, filt_w1, filt_b1, filt_w2, filt_b2,
                filt_w3, filt_b3, filt_w4, filt_freq, filt_skip, fnet_w, fnet_b,
                norm_hy, norm_fn, w_out):
    B, L, _ = x.shape
    h = rmsnorm(x, norm_g)
    proj = h @ w_in
    u_hy = proj[..., :3 * D_HYENA]
    z_hy = proj[..., 3 * D_HYENA:4 * D_HYENA]
    u_fn = proj[..., 4 * D_HYENA:4 * D_HYENA + D_FNET]
    z_fn = proj[..., 4 * D_HYENA + D_FNET:]

    u_hy = centred_short_conv(u_hy, conv_w, conv_b)
    x1 = u_hy[..., :D_HYENA]
    x2 = u_hy[..., D_HYENA:2 * D_HYENA]
    v = u_hy[..., 2 * D_HYENA:]
    filt = hyena_filters(L, filt_w1, filt_b1, filt_w2, filt_b2, filt_w3, filt_b3,
                         filt_w4, filt_freq, x.dtype)
    zz = x1 * bidir_long_conv(v, filt[:, 0, 0], filt[:, 0, 1], filt_skip[0])
    zz = x2 * bidir_long_conv(zz, filt[:, 1, 0], filt[:, 1, 1], filt_skip[1])
    y_hy = rmsnorm(zz * jax.nn.silu(z_hy), norm_hy)

    ug = u_fn.astype(jnp.float32).reshape(B, L, FNET_GROUPS, FNET_GROUP_DIM)
    fg = jnp.fft.fft2(ug, axes=(1, 3), norm="ortho").real.astype(x.dtype)
    yg = jnp.einsum("blgc,gcd->blgd", fg, fnet_w) + fnet_b.reshape(FNET_GROUPS, FNET_GROUP_DIM)
    y_fn = rmsnorm(yg.reshape(B, L, D_FNET) * jax.nn.silu(z_fn), norm_fn)

    y = jnp.concatenate([y_hy, y_fn], axis=-1) @ w_out
    return x + y


def encoder_trunk(x, norm_g, w_in, conv_w, conv_b, filt_w1, filt_b1, filt_w2, filt_b2,
                  filt_w3, filt_b3, filt_w4, filt_freq, filt_skip, fnet_w, fnet_b,
                  norm_hy, norm_fn, w_out, final_norm):
    for l in range(DEPTH):
        x = mixer_layer(x, norm_g[l], w_in[l], conv_w[l], conv_b[l], filt_w1[l], filt_b1[l],
                        filt_w2[l], filt_b2[l], filt_w3[l], filt_b3[l], filt_w4[l],
                        filt_freq[l], filt_skip[l], fnet_w[l], fnet_b[l],
                        norm_hy[l], norm_fn[l], w_out[l])
    return rmsnorm(x, final_norm)


def setup_inputs(seed: int = 0) -> dict:
    key = jax.random.key(seed)
    ks = jax.random.split(key, 24)
    f32 = jnp.float32
    nrm = lambda k, shape, s: (jax.random.normal(k, shape, f32) * s)
    return {
        "x_prompt": nrm(ks[0], (BATCH, SEQ, D_MODEL), 1.0),
        "x_sample": nrm(ks[1], (DEC_BATCH, DEC_SEQ, D_MODEL), 1.0),
        "norm_g": 1.0 + nrm(ks[2], (DEPTH, D_MODEL), 0.01),
        "w_in": nrm(ks[3], (DEPTH, D_MODEL, D_PROJ), D_MODEL ** -0.5),
        "conv_w": nrm(ks[4], (DEPTH, SHORT_CONV, 3 * D_HYENA), SHORT_CONV ** -0.5),
        "conv_b": nrm(ks[5], (DEPTH, 3 * D_HYENA), 0.01),
        "filt_w1": nrm(ks[6], (DEPTH, FILTER_EMB, FILTER_HIDDEN), FILTER_EMB ** -0.5),
        "filt_b1": nrm(ks[7], (DEPTH, FILTER_HIDDEN), 0.01),
        "filt_w2": nrm(ks[8], (DEPTH, FILTER_HIDDEN, FILTER_HIDDEN), FILTER_HIDDEN ** -0.5),
        "filt_b2": nrm(ks[9], (DEPTH, FILTER_HIDDEN), 0.01),
        "filt_w3": nrm(ks[10], (DEPTH, FILTER_HIDDEN, FILTER_HIDDEN), FILTER_HIDDEN ** -0.5),
        "filt_b3": nrm(ks[11], (DEPTH, FILTER_HIDDEN), 0.01),
        "filt_w4": nrm(ks[12], (DEPTH, FILTER_HIDDEN, HYENA_ORDER * N_DIR * D_HYENA), 0.05 * FILTER_HIDDEN ** -0.5),
        "filt_freq": 1.0 + nrm(ks[13], (DEPTH, FILTER_HIDDEN), 0.01),
        "filt_skip": nrm(ks[14], (DEPTH, HYENA_ORDER, D_HYENA), 1.0),
        "fnet_w": nrm(ks[15], (DEPTH, FNET_GROUPS, FNET_GROUP_DIM, FNET_GROUP_DIM), FNET_GROUP_DIM ** -0.5),
        "fnet_b": nrm(ks[16], (DEPTH, D_FNET), 0.01),
        "norm_hy": 1.0 + nrm(ks[17], (DEPTH, D_HYENA), 0.01),
        "norm_fn": 1.0 + nrm(ks[18], (DEPTH, D_FNET), 0.01),
        "w_out": nrm(ks[19], (DEPTH, D_MIX, D_MODEL), D_MIX ** -0.5),
        "final_norm": 1.0 + nrm(ks[20], (D_MODEL,), 0.01),
    }


def reference(x_prompt, x_sample, norm_g, w_in, conv_w, conv_b, filt_w1, filt_b1, filt_w2,
              filt_b2, filt_w3, filt_b3, filt_w4, filt_freq, filt_skip, fnet_w, fnet_b,
              norm_hy, norm_fn, w_out, final_norm):
    y_prompt = encoder_trunk(x_prompt, norm_g, w_in, conv_w, conv_b, filt_w1, filt_b1, filt_w2,
                             filt_b2, filt_w3, filt_b3, filt_w4, filt_freq, filt_skip, fnet_w,
                             fnet_b, norm_hy, norm_fn, w_out, final_norm)
    y_sample = encoder_trunk(x_sample, norm_g, w_in, conv_w, conv_b, filt_w1, filt_b1, filt_w2,
                             filt_b2, filt_w3, filt_b3, filt_w4, filt_freq, filt_skip, fnet_w,
                             fnet_b, norm_hy, norm_fn, w_out, final_norm)
    return (y_prompt, y_sample)
```

```cpp
#include <hip/hip_runtime.h>
#include <hip/hip_cooperative_groups.h>
#include <cstdio>
#include <cmath>
namespace cg = cooperative_groups;

#ifndef PROBE_REP
#define PROBE_REP -1
#endif
#ifndef N_LAUNCH_MODE
#define N_LAUNCH_MODE 1
#endif

#define HD __host__ __device__ __forceinline__
#define DV __device__ __forceinline__
#define LAS __attribute__((address_space(3)))
typedef unsigned short bf16_t;
typedef short bf16x8 __attribute__((ext_vector_type(8)));
typedef float f32x4 __attribute__((ext_vector_type(4)));
typedef float f32x16 __attribute__((ext_vector_type(16)));
typedef unsigned u32x4 __attribute__((ext_vector_type(4)));
typedef unsigned u32x2 __attribute__((ext_vector_type(2)));

constexpr int DM = 2048, NTOK = 32768, LP = 16384, LS = 8192, NTHR = 512;
constexpr size_t MiB = 1ull << 20;
constexpr size_t WS_A = 0;
constexpr size_t WS_B = 128 * MiB;
constexpr size_t WS_W1T = 448 * MiB;
constexpr size_t WS_WOT = 476 * MiB;
constexpr size_t WS_RS = 484 * MiB;
constexpr size_t WS_H3 = WS_RS + 128 * 1024;
constexpr size_t WS_W4T = WS_H3 + 3 * MiB;
constexpr size_t WS_TF = WS_W4T + 512 * 1024;
constexpr size_t WS_SSQ = WS_TF + 2 * MiB;
constexpr size_t WS_BAR = WS_SSQ + 4 * MiB;
constexpr size_t WS_WFT = WS_BAR + 16384;
constexpr size_t WS_BMIX = WS_WFT;
constexpr size_t WS_NYQ = WS_SSQ;
constexpr size_t WS_END = WS_WFT + 8 * MiB;
constexpr size_t OUT_KFP = 0, OUT_ZT = 128 * MiB;
constexpr int LDS_BYTES = 139264;

HD unsigned f2bf(float f) { unsigned u = __builtin_bit_cast(unsigned, f); u += 0x7FFFu + ((u >> 16) & 1u); return u >> 16; }
HD float bf2f(unsigned b) { return __builtin_bit_cast(float, b << 16); }
HD unsigned pack_bf2(float lo, float hi) { return f2bf(lo) | (f2bf(hi) << 16); }
HD unsigned pack_h2(float lo, float hi) { _Float16 a = (_Float16)lo, b = (_Float16)hi; return (unsigned)__builtin_bit_cast(unsigned short, a) | ((unsigned)__builtin_bit_cast(unsigned short, b) << 16); }
HD float h_lo(unsigned u) { return (float)__builtin_bit_cast(_Float16, (unsigned short)(u & 0xffffu)); }
HD float h_hi(unsigned u) { return (float)__builtin_bit_cast(_Float16, (unsigned short)(u >> 16)); }
HD void sincos_rev(float rev, float& c, float& s) {
#ifdef __HIP_DEVICE_COMPILE__
    c = __builtin_amdgcn_cosf(rev); s = __builtin_amdgcn_sinf(rev);
#else
    c = cosf(6.283185307179586f * rev); s = sinf(6.283185307179586f * rev);
#endif
}
HD unsigned brev(unsigned x, int nb) { return __builtin_bitreverse32(x) >> (32 - nb); }
#define LPAD(i) ((i) + ((i) >> 5))
HD u32x4 ldnt4(const void* p) { return __builtin_nontemporal_load((const u32x4*)p); }
HD u32x2 ldnt2(const void* p) { return __builtin_nontemporal_load((const u32x2*)p); }
#define SCHED_FENCE()

HD constexpr float c32(int k) {
    return k == 0 ? 1.0f : k == 1 ? 0.98078528040323043f : k == 2 ? 0.92387953251128674f : k == 3 ? 0.83146961230254524f : k == 4 ? 0.70710678118654752f :
           k == 5 ? 0.55557023301960218f : k == 6 ? 0.38268343236508977f : k == 7 ? 0.19509032201612825f : k == 8 ? 0.0f :
           k == 9 ? -0.19509032201612825f : k == 10 ? -0.38268343236508977f : k == 11 ? -0.55557023301960218f : k == 12 ? -0.70710678118654752f :
           k == 13 ? -0.83146961230254524f : k == 14 ? -0.92387953251128674f : -0.98078528040323043f;
}
HD constexpr float s32(int k) {
    return k == 0 ? 0.0f : k == 1 ? 0.19509032201612825f : k == 2 ? 0.38268343236508977f : k == 3 ? 0.55557023301960218f : k == 4 ? 0.70710678118654752f :
           k == 5 ? 0.83146961230254524f : k == 6 ? 0.92387953251128674f : k == 7 ? 0.98078528040323043f : k == 8 ? 1.0f :
           k == 9 ? 0.98078528040323043f : k == 10 ? 0.92387953251128674f : k == 11 ? 0.83146961230254524f : k == 12 ? 0.70710678118654752f :
           k == 13 ? 0.55557023301960218f : k == 14 ? 0.38268343236508977f : 0.19509032201612825f;
}
HD constexpr int brev_c(int x, int nb) { return ((((x & 1) << 4) | ((x & 2) << 2) | (x & 4) | ((x & 8) >> 2) | ((x & 16) >> 4)) >> (5 - nb)); }

typedef float v2f __attribute__((ext_vector_type(2)));
HD v2f cmul(v2f x, v2f w) { return x * w.xx + x.yx * (v2f){-w.y, w.y}; }
template <int RL, bool ZH = false> HD void dif_regs(v2f (&x)[1 << RL]) {
    constexpr int R = 1 << RL;
#pragma unroll
    for (int q = 0; q < RL; ++q) {
        const int half = R >> (q + 1);
#pragma unroll
        for (int j = 0; j < R; ++j) {
            if (j & half) continue;
            const int k32 = ((j & (half - 1)) << q) * (32 / R);
            const v2f a = x[j], b = x[j + half];
            const bool zb = ZH && q == 0;
            x[j] = zb ? a : a + b;
            const v2f d = zb ? a : a - b;
            if (k32 == 0) x[j + half] = d;
            else if (k32 == 8) x[j + half] = (v2f){d.y, -d.x};
            else x[j + half] = cmul(d, (v2f){c32(k32), -s32(k32)});
        }
    }
}
template <int RL, bool LH = false> HD void dit_regs(v2f (&x)[1 << RL]) {
    constexpr int R = 1 << RL;
#pragma unroll
    for (int q = RL - 1; q >= 0; --q) {
        const int half = R >> (q + 1);
#pragma unroll
        for (int j = 0; j < R; ++j) {
            if (j & half) continue;
            const int k32 = ((j & (half - 1)) << q) * (32 / R);
            const v2f a = x[j], b = x[j + half];
            v2f t;
            if (k32 == 0) t = b;
            else if (k32 == 8) t = (v2f){-b.y, b.x};
            else t = cmul(b, (v2f){c32(k32), s32(k32)});
            x[j] = a + t; if (!(LH && q == 0)) x[j + half] = a - t;
        }
    }
}
template <int RL> HD void apply_tw(v2f (&x)[1 << RL], v2f t) {
    constexpr int R = 1 << RL;
    v2f p[4];
    p[0] = (v2f){1.f, 0.f}; p[1] = t; p[2] = cmul(t, t); p[3] = cmul(p[2], t);
    const v2f p4 = cmul(p[2], p[2]);
    v2f bs = p4;
#pragma unroll
    for (int a = 0; a < R / 4; ++a) {
#pragma unroll
        for (int b = 0; b < 4; ++b) {
            const int f = 4 * a + b;
            if (f == 0) continue;
            const v2f w = (a == 0) ? p[b] : (b == 0 ? bs : cmul(bs, p[b]));
            const int e = brev_c(f, RL);
            x[e] = cmul(x[e], w);
        }
        if (a > 0) bs = cmul(bs, p4);
        SCHED_FENCE();
    }
}
template <int SH> HD constexpr int poff(int e) { return (e << SH) + (SH >= 5 ? (e << (SH >= 5 ? SH - 5 : 0)) : (SH == 4 ? (e >> 1) : 0)); }
template <int RL, int SH, bool INV, bool HALF = false> HD void fft_pass(float2* lds, int tid) {
    constexpr int R = 1 << RL, NB = 16384 >> RL;
    static_assert(SH >= 4 || (SH == 0 && RL <= 5), "unsupported pass geometry");
#ifdef __HIP_DEVICE_COMPILE__
    asm volatile("" : "+v"(tid));
#endif
    static_assert(NB % NTHR == 0, "pass geometry");
#pragma unroll
    for (int it = 0; it < NB / NTHR; ++it) {
        const int b = tid + it * NTHR;
        const int lo = b & ((1 << SH) - 1), hi = b >> SH;
        const int base = (hi << (SH + RL)) | lo;
        v2f* pb = (v2f*)lds + LPAD(base);
        v2f x[R];
#pragma unroll
        for (int e = 0; e < R; ++e) x[e] = (HALF && !INV && e >= R / 2) ? (v2f){0.f, 0.f} : pb[poff<SH>(e)];
        float c = 1.f, s = 0.f;
        if (SH > 0) sincos_rev((float)lo * (1.0f / (float)(1 << (SH + RL))), c, s);
        SCHED_FENCE();
        if (!INV) { dif_regs<RL, HALF>(x); SCHED_FENCE(); if (SH > 0) apply_tw<RL>(x, (v2f){c, -s}); }
        else { if (SH > 0) apply_tw<RL>(x, (v2f){c, s}); SCHED_FENCE(); dit_regs<RL, HALF>(x); }
        SCHED_FENCE();
#pragma unroll
        for (int e = 0; e < R; ++e) if (!(HALF && INV && e >= R / 2)) pb[poff<SH>(e)] = x[e];
    }
}

template <int NB> HD int pair_k(int tid, int i) { constexpr int IB = NB - 10; return ((tid & 63) << (3 + IB)) | ((tid >> 6) << IB) | i; }
template <int NB> HD int fz_k(int tp, int item) {
    constexpr int NBB = NB - 4;
    if (tp != 0) return ((int)brev((unsigned)item, 4) << NBB) | (int)brev((unsigned)tp, NBB - 1);
    if (item < 8) return ((int)brev((unsigned)item, 4) << NBB) | (1 << (NBB - 1));
    return (item - 8) << NBB;
}
template <int NB, int NSEQ> HD void kf_pairs(float2* lds, int tid, uint2* kf0, uint2* kf1) {
    constexpr int N = 1 << NB, TPS = NTHR / NSEQ;
#ifdef __HIP_DEVICE_COMPILE__
    asm volatile("" : "+v"(tid));
#endif
    const int q = tid / TPS, tp = tid % TPS, base = q * N;
    uint2* kf = q ? kf1 : kf0;
    for (int item = 0; item < 16; ++item) {
        const int k = fz_k<NB>(tp, item);
        float wc, ws; sincos_rev((float)k * (0.5f / (float)N), wc, ws);
        uint2 o;
        if (k == 0) {
            const float2 z0 = lds[LPAD(base)], zh = lds[LPAD(base + 1)];
            o.x = pack_h2(z0.x + z0.y, z0.x - z0.y); o.y = pack_h2(zh.x, -zh.y);
        } else {
            const float2 zk = lds[LPAD(base + (int)brev(k, NB))], zn = lds[LPAD(base + (int)brev(N - k, NB))];
            const float er = 0.5f * (zk.x + zn.x), ei = 0.5f * (zk.y - zn.y);
            const float orr = 0.5f * (zk.y + zn.y), oi = -0.5f * (zk.x - zn.x);
            const float pr = wc * orr + ws * oi, pi = wc * oi - ws * orr;
            o.x = pack_h2(er + pr, ei + pi); o.y = pack_h2(er - pr, -(ei - pi));
        }
        kf[item * TPS + tp] = o;
    }
}
template <int NB, int NSEQ> HD void kf_prefetch(const uint2* kf, int tid, uint2 (&sl)[16]) {
    constexpr int TPS = NTHR / NSEQ; const int tp = tid % TPS;
#pragma unroll
    for (int i = 0; i < 16; ++i) { const u32x2 v = ldnt2(kf + i * TPS + tp); sl[i].x = v.x; sl[i].y = v.y; }
}
template <int NB> HD void pair_mix(v2f& zk, v2f& zn, int k, uint2 sl) {
    constexpr int N = 1 << NB; const float invN = 1.0f / (float)N;
    const float k0 = h_lo(sl.x), k1 = h_hi(sl.x), k2 = h_lo(sl.y), k3 = h_hi(sl.y);
    float wc, ws; sincos_rev((float)k * (0.5f / (float)N), wc, ws);
    const float er = 0.5f * (zk.x + zn.x), ei = 0.5f * (zk.y - zn.y);
    const float orr = 0.5f * (zk.y + zn.y), oi = -0.5f * (zk.x - zn.x);
    const float pr = wc * orr + ws * oi, pi = wc * oi - ws * orr;
    const float xkr = er + pr, xki = ei + pi, xnr = er - pr, xni = -(ei - pi);
    const float ykr = xkr * k0 - xki * k1, yki = xkr * k1 + xki * k0;
    const float ynr = xnr * k2 - xni * k3, yni = xnr * k3 + xni * k2;
    const float yer = 0.5f * (ykr + ynr), yei = 0.5f * (yki - yni);
    const float dr = 0.5f * (ykr - ynr), di = 0.5f * (yki + yni);
    const float yor = dr * wc - di * ws, yoi = dr * ws + di * wc;
    zk = (v2f){(yer - yoi) * invN, (yei + yor) * invN};
    zn = (v2f){(yer + yoi) * invN, (-yei + yor) * invN};
}
template <int NB, int NSEQ> HD void conv_mid(float2* lds, int tid, const uint2 (&slots)[16]) {
    constexpr int N = 1 << NB, NBB = NB - 4, TPS = NTHR / NSEQ;
    const float invN = 1.0f / (float)N;
#ifdef __HIP_DEVICE_COMPILE__
    asm volatile("" : "+v"(tid));
#endif
    const int q = tid / TPS, tp = tid % TPS, base = q * N;
    const int bA = 2 * tp, bB = tp ? (int)brev((unsigned)((1 << NBB) - (int)brev((unsigned)bA, NBB)), NBB) : 1;
    v2f* pA = (v2f*)lds + LPAD(base + 16 * bA); v2f* pB = (v2f*)lds + LPAD(base + 16 * bB);
    v2f xa[16], xb[16];
#pragma unroll
    for (int e = 0; e < 16; ++e) { xa[e] = pA[e]; xb[e] = pB[e]; }
    dif_regs<4>(xa); dif_regs<4>(xb);
    if (tp != 0) {
#pragma unroll
        for (int e = 0; e < 16; ++e) pair_mix<NB>(xa[e], xb[15 - e], ((int)brev_c(e, 4) << NBB) | (int)brev((unsigned)tp, NBB - 1), slots[e]);
    } else {
#pragma unroll
        for (int e = 0; e < 8; ++e) pair_mix<NB>(xb[e], xb[15 - e], ((int)brev_c(e, 4) << NBB) | (1 << (NBB - 1)), slots[e]);
        {
            const float k0 = h_lo(slots[8].x), k1 = h_hi(slots[8].x), k2 = h_lo(slots[8].y), k3 = h_hi(slots[8].y);
            const v2f z0 = xa[0], zh = xa[1];
            const float y0 = (z0.x + z0.y) * k0, yn = (z0.x - z0.y) * k1;
            xa[0] = (v2f){0.5f * (y0 + yn) * invN, 0.5f * (y0 - yn) * invN};
            const float yr = zh.x * k2 + zh.y * k3, yi = zh.x * k3 - zh.y * k2;
            xa[1] = (v2f){yr * invN, -yi * invN};
        }
#pragma unroll
        for (int E = 1; E < 8; ++E) pair_mix<NB>(xa[brev_c(E, 4)], xa[brev_c(16 - E, 4)], E << NBB, slots[8 + E]);
    }
    dit_regs<4>(xa); dit_regs<4>(xb);
#pragma unroll
    for (int e = 0; e < 16; ++e) { pA[e] = xa[e]; pB[e] = xb[e]; }
}

template <int NB> HD uint2 kf_spec(v2f zk, v2f zn, int k) {
    constexpr int N = 1 << NB;
    float wc, ws; sincos_rev((float)k * (0.5f / (float)N), wc, ws);
    const float er = 0.5f * (zk.x + zn.x), ei = 0.5f * (zk.y - zn.y);
    const float orr = 0.5f * (zk.y + zn.y), oi = -0.5f * (zk.x - zn.x);
    const float pr = wc * orr + ws * oi, pi = wc * oi - ws * orr;
    uint2 o; o.x = pack_h2(er + pr, ei + pi); o.y = pack_h2(er - pr, -(ei - pi)); return o;
}
template <int NB, int NSEQ> HD void kf_mid(float2* lds, int tid, uint2* kf0, uint2* kf1) {
    constexpr int N = 1 << NB, NBB = NB - 4, TPS = NTHR / NSEQ;
#ifdef __HIP_DEVICE_COMPILE__
    asm volatile("" : "+v"(tid));
#endif
    const int q = tid / TPS, tp = tid % TPS, base = q * N;
    uint2* kf = (q ? kf1 : kf0) + tp;
    const int bA = 2 * tp, bB = tp ? (int)brev((unsigned)((1 << NBB) - (int)brev((unsigned)bA, NBB)), NBB) : 1;
    const v2f* pA = (const v2f*)lds + LPAD(base + 16 * bA); const v2f* pB = (const v2f*)lds + LPAD(base + 16 * bB);
    v2f xa[16], xb[16];
#pragma unroll
    for (int e = 0; e < 16; ++e) { xa[e] = pA[e]; xb[e] = pB[e]; }
    dif_regs<4>(xa); dif_regs<4>(xb);
    if (tp != 0) {
#pragma unroll
        for (int e = 0; e < 16; ++e) kf[e * TPS] = kf_spec<NB>(xa[e], xb[15 - e], ((int)brev_c(e, 4) << NBB) | (int)brev((unsigned)tp, NBB - 1));
    } else {
#pragma unroll
        for (int e = 0; e < 8; ++e) kf[e * TPS] = kf_spec<NB>(xb[e], xb[15 - e], ((int)brev_c(e, 4) << NBB) | (1 << (NBB - 1)));
        { const v2f z0 = xa[0], zh = xa[1]; uint2 o; o.x = pack_h2(z0.x + z0.y, z0.x - z0.y); o.y = pack_h2(zh.x, -zh.y); kf[8 * TPS] = o; }
#pragma unroll
        for (int E = 1; E < 8; ++E) kf[(8 + E) * TPS] = kf_spec<NB>(xa[brev_c(E, 4)], xa[brev_c(16 - E, 4)], E << NBB);
    }
}

namespace pg8 {
constexpr int BM = 256, BK = 64, HALF = 128, HTB = HALF * BK * 2, STAGE_BYTES = 8 * HTB, NXCD = 8, WGM = 8;
__host__ __device__ __forceinline__ int lds_byte(int r, int c) { const int st = (r >> 4) * 2 + (c >> 5), rr = r & 15, cc = c & 31, ob = rr * 64 + cc * 2; return st * 1024 + (ob ^ (((ob >> 9) & 1) << 5)); }
__host__ __device__ __forceinline__ void stage_rc(int b, int& R, int& C) { const int st = b / 1024, sb = b % 1024, swz = sb ^ (((sb >> 9) & 1) << 5); R = (st >> 1) * 16 + swz / 64; C = (st & 1) * 32 + (swz % 64) / 2; }
__host__ __device__ __forceinline__ int perm32(int rho) { const int n = rho >> 4, i = rho & 15; return 8 * (i >> 2) + 4 * n + (i & 3); }
struct Unit { int pm, pn; };
struct Gemm { const bf16_t* A; const bf16_t* Bt; int M, N, K; };
struct StaticOrder {
    int nM, nN, nwg, G, c;
    __host__ __device__ void init(int M, int N, int G_, int c_) { nM = M / BM; nN = N / BM; nwg = nM * nN; G = G_; c = c_; }
    __host__ __device__ bool next(int i, Unit& u) const {
        const long L = (long)i * G + c; if (L >= nwg) return false;
        int wgid = (int)L; { const int q = nwg / NXCD, r = nwg % NXCD, xcd = wgid % NXCD, off = wgid / NXCD; wgid = (xcd < r ? xcd * (q + 1) : r * (q + 1) + (xcd - r) * q) + off; }
        const int nig = WGM * nN, gid = wgid / nig, fm = gid * WGM, gsz = (nM - fm) < WGM ? (nM - fm) : WGM;
        u.pm = fm + ((wgid % nig) % gsz); u.pn = (wgid % nig) / gsz; return true;
    }
};
__device__ __forceinline__ unsigned cvt_pk_bf16(float lo, float hi) { unsigned r; asm volatile("v_cvt_pk_bf16_f32 %0, %1, %2" : "=v"(r) : "v"(lo), "v"(hi)); return r; }

template <class Epi>
__device__ __forceinline__ void gemm_phase(LAS unsigned char* lds, const Gemm g, const StaticOrder& S, const Epi& E) {
    const int tid = threadIdx.x, wid = __builtin_amdgcn_readfirstlane(tid >> 6), lane = tid & 63, wr = wid >> 2, wc = wid & 3, fr = lane & 15, fq = lane >> 4;
    const int K = g.K, nt = K / BK;
    unsigned voffA[2], voffB[2];
#pragma unroll
    for (int i = 0; i < 2; ++i) { int R, C; stage_rc(tid * 16 + i * 8192, R, C); const int Rb = Epi::PERM ? ((R & ~31) + perm32(R & 31)) : R;
        voffA[i] = (unsigned)(R * K + C) * 2u; voffB[i] = (unsigned)(Rb * K + C) * 2u; }
    const size_t kstep = (size_t)(BK * 2);
    const size_t hstep = (size_t)HALF * K * 2;
    const size_t tstep = 2 * hstep;
    const unsigned ldsw = (unsigned)wid * 1024u;
    const int aoff = lds_byte(wr * 64 + fr, fq * 8), boff = lds_byte(wc * 32 + fr, fq * 8);
#define PG8_SA(b, h) (((b) * 2 + (h)) * HTB)
#define PG8_SB(b, h) ((4 + (b) * 2 + (h)) * HTB)
#define PG8_STAGE(bufoff, gbase, voff) do { _Pragma("unroll") for (int _i = 0; _i < 2; ++_i) \
        __builtin_amdgcn_global_load_lds((const unsigned*)((const char*)(gbase) + (voff)[_i]), (LAS unsigned*)(lds + (bufoff) + ldsw + _i * 8192), 16, 0, 0); } while (0)
#define PG8_LDA(dst, b, h) do { _Pragma("unroll") for (int m = 0; m < 4; ++m) _Pragma("unroll") for (int k = 0; k < 2; ++k) dst[m][k] = *(const LAS bf16x8*)(lds + PG8_SA(b, h) + aoff + m * 2048 + k * 1024); } while (0)
#define PG8_LDB(dst, b, h) do { _Pragma("unroll") for (int n = 0; n < 2; ++n) _Pragma("unroll") for (int k = 0; k < 2; ++k) dst[n][k] = *(const LAS bf16x8*)(lds + PG8_SB(b, h) + boff + n * 2048 + k * 1024); } while (0)
#define PG8_MMA(ai, bj, At, Bt) do { __builtin_amdgcn_s_setprio(1); _Pragma("unroll") for (int m = 0; m < 4; ++m) _Pragma("unroll") for (int n = 0; n < 2; ++n) _Pragma("unroll") for (int k = 0; k < 2; ++k) \
        acc[ai][bj][m][n] = __builtin_amdgcn_mfma_f32_16x16x32_bf16(Bt[n][k], At[m][k], acc[ai][bj][m][n], 0, 0, 0); __builtin_amdgcn_s_setprio(0); } while (0)
#define PG8_WAIT_V(n) asm volatile("s_waitcnt vmcnt(" #n ")" ::: "memory")
#define PG8_WAIT_L(n) asm volatile("s_waitcnt lgkmcnt(" #n ")" ::: "memory")
#define PG8_BAR __builtin_amdgcn_s_barrier()
#define PG8_SCHED __builtin_amdgcn_sched_barrier(0)
    Unit cur, nxt; int ui = 0;
    if (!S.next(0, cur)) return;
    f32x4 acc[2][2][4][2];
#pragma unroll
    for (int a = 0; a < 2; ++a)
#pragma unroll
        for (int b = 0; b < 2; ++b)
#pragma unroll
            for (int m = 0; m < 4; ++m)
#pragma unroll
                for (int n = 0; n < 2; ++n) acc[a][b][m][n] = (f32x4){0.f, 0.f, 0.f, 0.f};
    bf16x8 At[4][2], B0[2][2], B1[2][2];
    const char* cA = (const char*)g.A + (size_t)cur.pm * tstep; const char* cB = (const char*)g.Bt + (size_t)cur.pn * tstep;
    PG8_STAGE(PG8_SB(0, 0), cB, voffB); PG8_STAGE(PG8_SA(0, 0), cA, voffA); PG8_STAGE(PG8_SB(0, 1), cB + hstep, voffB); PG8_STAGE(PG8_SA(0, 1), cA + hstep, voffA);
    if (wr == 1) PG8_BAR;
    PG8_WAIT_V(4); PG8_BAR;
    PG8_STAGE(PG8_SB(1, 0), cB + kstep, voffB); PG8_STAGE(PG8_SA(1, 0), cA + kstep, voffA); PG8_STAGE(PG8_SB(1, 1), cB + hstep + kstep, voffB);
    PG8_WAIT_V(6); PG8_BAR;
    for (;;) {
        const bool has_next = S.next(ui + 1, nxt);
        const char* nA = has_next ? (const char*)g.A + (size_t)nxt.pm * tstep : cA; const char* nB = has_next ? (const char*)g.Bt + (size_t)nxt.pn * tstep : cB;
        for (int t = 0; t < nt; t += 2) {
            const bool last = (t == nt - 2);
            const char* a1 = cA + (size_t)(t + 1) * kstep;
            const char* a2 = last ? nA : cA + (size_t)(t + 2) * kstep; const char* b2 = last ? nB : cB + (size_t)(t + 2) * kstep;
            const char* a3 = a2 + kstep; const char* b3 = b2 + kstep;
            PG8_LDB(B0, 0, 0); PG8_SCHED; PG8_LDA(At, 0, 0); PG8_STAGE(PG8_SA(1, 1), a1 + hstep, voffA);
            PG8_WAIT_L(8); PG8_BAR; PG8_WAIT_L(0); PG8_MMA(0, 0, At, B0); PG8_BAR; PG8_SCHED;
            PG8_LDB(B1, 0, 1); PG8_STAGE(PG8_SB(0, 0), b2, voffB);
            PG8_BAR; PG8_WAIT_L(0); PG8_MMA(0, 1, At, B1); PG8_BAR;
            PG8_LDA(At, 0, 1); PG8_STAGE(PG8_SA(0, 0), a2, voffA);
            PG8_BAR; PG8_WAIT_L(0); PG8_MMA(1, 0, At, B0); PG8_BAR; PG8_SCHED;
            PG8_STAGE(PG8_SB(0, 1), b2 + hstep, voffB);
            PG8_WAIT_V(6); PG8_BAR; PG8_MMA(1, 1, At, B1); PG8_BAR;
            PG8_LDB(B0, 1, 0); PG8_SCHED; PG8_LDA(At, 1, 0); PG8_STAGE(PG8_SA(0, 1), a2 + hstep, voffA);
            PG8_WAIT_L(8); PG8_BAR; PG8_WAIT_L(0); PG8_MMA(0, 0, At, B0); PG8_BAR; PG8_SCHED;
            PG8_LDB(B1, 1, 1); PG8_STAGE(PG8_SB(1, 0), b3, voffB);
            PG8_BAR; PG8_WAIT_L(0); PG8_MMA(0, 1, At, B1); PG8_BAR;
            PG8_LDA(At, 1, 1); PG8_STAGE(PG8_SA(1, 0), a3, voffA);
            PG8_BAR; PG8_WAIT_L(0); PG8_MMA(1, 0, At, B0); PG8_BAR; PG8_SCHED;
            PG8_STAGE(PG8_SB(1, 1), b3 + hstep, voffB);
            PG8_WAIT_V(6); PG8_BAR; PG8_MMA(1, 1, At, B1); PG8_BAR;
        }
        E(acc, cur, wr, wc, fr, fq);
        if (!has_next) break;
#pragma unroll
        for (int a = 0; a < 2; ++a)
#pragma unroll
            for (int b = 0; b < 2; ++b)
#pragma unroll
                for (int m = 0; m < 4; ++m)
#pragma unroll
                    for (int n = 0; n < 2; ++n) acc[a][b][m][n] = (f32x4){0.f, 0.f, 0.f, 0.f};
        cur = nxt; cA = nA; cB = nB; ++ui;
    }
    PG8_WAIT_V(0);
    if (wr == 0) PG8_BAR;
    PG8_BAR;
#undef PG8_SA
#undef PG8_SB
#undef PG8_STAGE
#undef PG8_LDA
#undef PG8_LDB
#undef PG8_MMA
#undef PG8_WAIT_V
#undef PG8_WAIT_L
#undef PG8_BAR
#undef PG8_SCHED
}

struct EpiPT {
    static constexpr bool PERM = true;
    bf16_t* O; int ldc; const float* cs;
    __device__ __forceinline__ void operator()(const f32x4 (&acc)[2][2][4][2], const Unit& u, int wr, int wc, int fr, int fq) const {
        const int row0 = u.pm * BM + wr * 64 + fr, col0 = u.pn * BM + wc * 32 + 8 * fq;
        f32x4 sv[2][2];
#pragma unroll
        for (int bj = 0; bj < 2; ++bj)
#pragma unroll
            for (int n = 0; n < 2; ++n) sv[bj][n] = *(const f32x4*)(cs + col0 + bj * HALF + 4 * n);
#pragma unroll
        for (int ai = 0; ai < 2; ++ai)
#pragma unroll
            for (int m = 0; m < 4; ++m) { bf16_t* rowp = O + (size_t)(row0 + ai * HALF + m * 16) * ldc + col0;
#pragma unroll
                for (int bj = 0; bj < 2; ++bj) { const f32x4 v0 = acc[ai][bj][m][0] * sv[bj][0], v1 = acc[ai][bj][m][1] * sv[bj][1];
                    u32x4 w; w.x = cvt_pk_bf16(v0[0], v0[1]); w.y = cvt_pk_bf16(v0[2], v0[3]); w.z = cvt_pk_bf16(v1[0], v1[1]); w.w = cvt_pk_bf16(v1[2], v1[3]);
                    *(u32x4*)(rowp + bj * HALF) = w; } }
    }
};
__device__ __forceinline__ float silu_f(float z) { return z * __builtin_amdgcn_rcpf(1.0f + __expf(-z)); }
struct EpiZT {
    static constexpr bool PERM = true;
    bf16_t* O; int ldc; const float* rs;
    __device__ __forceinline__ void operator()(const f32x4 (&acc)[2][2][4][2], const Unit& u, int wr, int wc, int fr, int fq) const {
        const int row0 = u.pm * BM + wr * 64 + fr, col0 = u.pn * BM + wc * 32 + 8 * fq;
#pragma unroll
        for (int ai = 0; ai < 2; ++ai)
#pragma unroll
            for (int m = 0; m < 4; ++m) { const int row = row0 + ai * HALF + m * 16; const float s = rs[row]; bf16_t* rowp = O + (size_t)row * ldc + col0;
#pragma unroll
                for (int bj = 0; bj < 2; ++bj) { const f32x4 v0 = acc[ai][bj][m][0] * s, v1 = acc[ai][bj][m][1] * s;
                    u32x4 w; w.x = cvt_pk_bf16(v0[0], v0[1]); w.y = cvt_pk_bf16(v0[2], v0[3]); w.z = cvt_pk_bf16(v1[0], v1[1]); w.w = cvt_pk_bf16(v1[2], v1[3]);
                    *(u32x4*)(rowp + bj * HALF) = w; } }
    }
};
struct EpiY {
    static constexpr bool PERM = true;
    bf16_t* O; int ldc;
    __device__ __forceinline__ void operator()(const f32x4 (&acc)[2][2][4][2], const Unit& u, int wr, int wc, int fr, int fq) const {
        const int row0 = u.pm * BM + wr * 64 + fr, col0 = u.pn * BM + wc * 32 + 8 * fq;
#pragma unroll
        for (int ai = 0; ai < 2; ++ai)
#pragma unroll
            for (int m = 0; m < 4; ++m) { bf16_t* rowp = O + (size_t)(row0 + ai * HALF + m * 16) * ldc + col0;
#pragma unroll
                for (int bj = 0; bj < 2; ++bj) { const f32x4 v0 = acc[ai][bj][m][0], v1 = acc[ai][bj][m][1];
                    u32x4 w; w.x = cvt_pk_bf16(v0[0], v0[1]); w.y = cvt_pk_bf16(v0[2], v0[3]); w.z = cvt_pk_bf16(v1[0], v1[1]); w.w = cvt_pk_bf16(v1[2], v1[3]);
                    *(u32x4*)(rowp + bj * HALF) = w; } }
    }
};
struct EpiMix {
    static constexpr bool PERM = true;
    bf16_t* YG; const float* bias; int g, mirror;
    __device__ __forceinline__ void operator()(const f32x4 (&acc)[2][2][4][2], const Unit& u, int wr, int wc, int fr, int fq) const {
        const int r0 = u.pm * BM;
        const int L = r0 < 8192 ? LP : LS, kb = r0 < 8192 ? 0 : (r0 < 12288 ? 8192 : 12288), tok0 = r0 < 8192 ? 0 : (r0 < 12288 ? LP : LP + LS);
        const float scale = r0 < 8192 ? (1.0f / 2048.0f) : 0.00069053396600248786f;
        const int col0 = g * 256 + wc * 32 + 8 * fq;
        f32x4 bv[2][2];
#pragma unroll
        for (int bj = 0; bj < 2; ++bj)
#pragma unroll
            for (int n = 0; n < 2; ++n) bv[bj][n] = *(const f32x4*)(bias + col0 + bj * HALF + 4 * n);
#pragma unroll
        for (int ai = 0; ai < 2; ++ai)
#pragma unroll
            for (int m = 0; m < 4; ++m) { const int k = r0 - kb + wr * 64 + fr + ai * HALF + m * 16;
                if (mirror && k == 0) continue;
                bf16_t* rowp = YG + (size_t)(tok0 + (mirror ? L - k : k)) * 1024 + col0;
#pragma unroll
                for (int bj = 0; bj < 2; ++bj) { const f32x4 v0 = acc[ai][bj][m][0] * scale + bv[bj][0], v1 = acc[ai][bj][m][1] * scale + bv[bj][1];
                    u32x4 w; w.x = cvt_pk_bf16(v0[0], v0[1]); w.y = cvt_pk_bf16(v0[2], v0[3]); w.z = cvt_pk_bf16(v1[0], v1[1]); w.w = cvt_pk_bf16(v1[2], v1[3]);
                    *(u32x4*)(rowp + bj * HALF) = w; } }
    }
};
struct EpiOut {
    static constexpr bool PERM = false;
    float* C; const float* xp; const float* xs; float* ssq;
    __device__ __forceinline__ void operator()(const f32x4 (&acc)[2][2][4][2], const Unit& u, int wr, int wc, int fr, int fq) const {
        const int row0 = u.pm * BM + wr * 64 + fr, col0 = u.pn * BM + wc * 32 + 4 * fq;
#pragma unroll
        for (int ai = 0; ai < 2; ++ai)
#pragma unroll
            for (int m = 0; m < 4; ++m) { const int row = row0 + ai * HALF + m * 16;
                const float* xr = (row < LP ? xp + (size_t)row * DM : xs + (size_t)(row - LP) * DM) + col0; float* cr = C + (size_t)row * DM + col0; float q = 0.f;
#pragma unroll
                for (int bj = 0; bj < 2; ++bj)
#pragma unroll
                    for (int n = 0; n < 2; ++n) { const f32x4 o = acc[ai][bj][m][n] + *(const f32x4*)(xr + bj * HALF + n * 16); *(f32x4*)(cr + bj * HALF + n * 16) = o;
                        q += (o[0] * o[0] + o[1] * o[1]) + (o[2] * o[2] + o[3] * o[3]); }
                q += __shfl_xor(q, 16); q += __shfl_xor(q, 32);
                if (fq == 0) ssq[(size_t)row * 32 + u.pn * 4 + wc] = q; }
    }
};
}


#define XB_TMO      128
#define XB_XCNT(j)  (256  + 64 * (j))
#define XB_XSUB(j)  (1280 + 64 * (j))
#define XB_XGEN(j)  (2304 + 64 * (j))
#define XB_TOP      3328
#define XB_TOPGEN   3392
#define XCD_BAR_WORDS 3456
#define XB_SPIN_CAP (1u << 20)
DV unsigned xb_ld(unsigned* p)              { return __hip_atomic_load(p, __ATOMIC_RELAXED, __HIP_MEMORY_SCOPE_AGENT); }
DV unsigned xb_add(unsigned* p, unsigned v) { return __hip_atomic_fetch_add(p, v, __ATOMIC_RELAXED, __HIP_MEMORY_SCOPE_AGENT); }
DV unsigned xb_xcc_id() { return (unsigned)__builtin_amdgcn_s_getreg((3 << 11) | 20) & 0xFu; }
#define XB_SPIN(cond, bar) do { unsigned _sp = 0; while (cond) { __builtin_amdgcn_s_sleep(1); \
    if ((++_sp & 255u) == 0u) { if (xb_ld(&(bar)[XB_TMO])) break; if (_sp > XB_SPIN_CAP) { atomicAdd(&(bar)[XB_TMO], 1u); break; } } } } while (0)
struct XcdBarrier { unsigned* bar; unsigned x; volatile LAS unsigned* st; };
DV XcdBarrier xcd_barrier_post(unsigned* bar, volatile LAS unsigned* st) {
    XcdBarrier b; b.bar = bar; b.x = xb_xcc_id(); b.st = st;
    if (threadIdx.x == 0) (void)xb_add(&bar[XB_XCNT(b.x)], 1u);
    return b;
}
DV void xcd_barrier_complete(unsigned* bar, unsigned x, unsigned& nloc, unsigned& nx) {
    const unsigned G = gridDim.x * gridDim.y * gridDim.z;
    unsigned sum, cnt, mine, sp = 0u;
    for (;;) {
        sum = 0u; cnt = 0u; mine = 0u;
#pragma unroll
        for (unsigned j = 0; j < 16; ++j) { const unsigned c = xb_ld(&bar[XB_XCNT(j)]); sum += c; cnt += (c > 0u) ? 1u : 0u; mine = (j == x) ? c : mine; }
        if (sum == G) break;
        __builtin_amdgcn_s_sleep(1);
        if ((++sp & 255u) == 0u) { if (xb_ld(&bar[XB_TMO])) break; if (sp > XB_SPIN_CAP) { atomicAdd(&bar[XB_TMO], 1u); break; } }
    }
    nloc = mine > 0u ? mine : 1u; nx = cnt > 0u ? cnt : 1u;
}
DV void xcd_barrier(const XcdBarrier& b) {
    asm volatile("s_waitcnt vmcnt(0)" ::: "memory");
    __syncthreads();
    if (threadIdx.x == 0) {
        unsigned* bar = b.bar;
        __builtin_amdgcn_s_waitcnt(0);
        unsigned nloc = b.st[0], nx = b.st[1];
        if (nloc == 0u) { xcd_barrier_complete(bar, b.x, nloc, nx); b.st[0] = nloc; b.st[1] = nx; }
        const unsigned old = xb_add(&bar[XB_XSUB(b.x)], 1u);
        const unsigned gen = old / nloc;
        if (old + 1u == (gen + 1u) * nloc) {
            __builtin_amdgcn_fence(__ATOMIC_RELEASE, "agent");
            asm volatile("s_waitcnt vmcnt(0)" ::: "memory");
            const unsigned og = xb_add(&bar[XB_TOP], 1u);
            const unsigned tg = og / nx;
            if (og + 1u == (tg + 1u) * nx) xb_add(&bar[XB_TOPGEN], 1u);
            else XB_SPIN(xb_ld(&bar[XB_TOPGEN]) == tg, bar);
            __builtin_amdgcn_fence(__ATOMIC_ACQUIRE, "agent");
            xb_add(&bar[XB_XGEN(b.x)], 1u);
            asm volatile("s_waitcnt vmcnt(0)" ::: "memory");
        } else {
            XB_SPIN(xb_ld(&bar[XB_XGEN(b.x)]) == gen, bar);
            __builtin_amdgcn_fence(__ATOMIC_ACQUIRE, "agent");
            asm volatile("s_waitcnt vmcnt(0)" ::: "memory");
        }
    }
    __syncthreads();
}

struct Params { const float* in[21]; float* out; unsigned char* ws; int ph_lo, ph_hi; };
enum { I_XP = 0, I_XS, I_NORMG, I_WIN, I_CONVW, I_CONVB, I_FW1, I_FB1, I_FW2, I_FB2, I_FW3, I_FB3, I_FW4, I_FREQ, I_SKIP, I_FNW, I_FNB, I_NHY, I_NFN, I_WOUT, I_FNORM };

DV float wave_sum(float v) {
#pragma unroll
    for (int o = 32; o > 0; o >>= 1) v += __shfl_xor(v, o);
    return v;
}

DV void transpose_tile(float* tl, const float* src, int ld, int k0, int c0, const float* sc, bf16_t* dst, int row0, int ldd, int lane) {
#pragma unroll
    for (int it = 0; it < 16; ++it) {
        const int k = it * 4 + (lane >> 4), cc = (lane & 15) * 4; const f32x4 a = *(const f32x4*)(src + (size_t)(k0 + k) * ld + c0 + cc);
        const float f = sc ? sc[k0 + k] : 1.0f; float* t = tl + k * 65 + cc; t[0] = a[0] * f; t[1] = a[1] * f; t[2] = a[2] * f; t[3] = a[3] * f;
    }
    asm volatile("s_waitcnt lgkmcnt(0)" ::: "memory"); __builtin_amdgcn_wave_barrier();
#pragma unroll
    for (int kc = 0; kc < 8; ++kc) {
        const int kk = kc * 8; u32x4 w;
        w.x = pack_bf2(tl[(kk + 0) * 65 + lane], tl[(kk + 1) * 65 + lane]); w.y = pack_bf2(tl[(kk + 2) * 65 + lane], tl[(kk + 3) * 65 + lane]);
        w.z = pack_bf2(tl[(kk + 4) * 65 + lane], tl[(kk + 5) * 65 + lane]); w.w = pack_bf2(tl[(kk + 6) * 65 + lane], tl[(kk + 7) * 65 + lane]);
        *(u32x4*)(dst + (size_t)(row0 + lane) * ldd + k0 + kk) = w;
    }
    asm volatile("s_waitcnt lgkmcnt(0)" ::: "memory"); __builtin_amdgcn_wave_barrier();
}

DV void transpose_tile_f32(float* tl, const float* src, int ld, int k0, int c0, const float* sc, float* dst, int row0, int ldd, int lane) {
#pragma unroll
    for (int it = 0; it < 16; ++it) {
        const int k = it * 4 + (lane >> 4), cc = (lane & 15) * 4; const f32x4 a = *(const f32x4*)(src + (size_t)(k0 + k) * ld + c0 + cc);
        const float f = sc ? sc[k0 + k] : 1.0f; float* t = tl + k * 65 + cc; t[0] = a[0] * f; t[1] = a[1] * f; t[2] = a[2] * f; t[3] = a[3] * f;
    }
    asm volatile("s_waitcnt lgkmcnt(0)" ::: "memory"); __builtin_amdgcn_wave_barrier();
#pragma unroll
    for (int kc = 0; kc < 16; ++kc) {
        const int kk = kc * 4; f32x4 w; w[0] = tl[(kk + 0) * 65 + lane]; w[1] = tl[(kk + 1) * 65 + lane]; w[2] = tl[(kk + 2) * 65 + lane]; w[3] = tl[(kk + 3) * 65 + lane];
        *(f32x4*)(dst + (size_t)(row0 + lane) * ldd + k0 + kk) = w;
    }
    asm volatile("s_waitcnt lgkmcnt(0)" ::: "memory"); __builtin_amdgcn_wave_barrier();
}

DV void phase0(const Params& p, unsigned char* lds_raw) {
    const int tid = threadIdx.x, lane = tid & 63, wid = tid >> 6, G0 = gridDim.x, bx0 = blockIdx.x;
    unsigned char* ws = p.ws;
    const int NTF = G0 > 32 ? 16 : 0;
    const bool tf_role = NTF == 0 || bx0 < NTF, common_role = NTF == 0 || bx0 >= NTF;
    const int G = common_role ? G0 - NTF : G0, bx = common_role ? bx0 - NTF : bx0;
    if (common_role) {
        bf16_t* XB = (bf16_t*)(ws + WS_A);
        for (int row0 = bx * 8 + wid; row0 < NTOK; row0 += 2 * G * 8) {
            const int rows[2] = {row0, row0 + G * 8};
            f32x4 va[2][4], vb[2][4];
#pragma unroll
            for (int u = 0; u < 2; ++u) { const int row = rows[u] < NTOK ? rows[u] : row0;
                const float* xr = row < LP ? p.in[I_XP] + (size_t)row * DM : p.in[I_XS] + (size_t)(row - LP) * DM;
#pragma unroll
                for (int j = 0; j < 4; ++j) { const int c = j * 512 + lane * 8; va[u][j] = __builtin_nontemporal_load((const f32x4*)(xr + c)); vb[u][j] = __builtin_nontemporal_load((const f32x4*)(xr + c + 4)); } }
#pragma unroll
            for (int u = 0; u < 2; ++u) { const int row = rows[u]; if (row >= NTOK) continue;
                float q = 0.f;
#pragma unroll
                for (int j = 0; j < 4; ++j) { const f32x4 a = va[u][j], b = vb[u][j];
                    q += (a[0] * a[0] + a[1] * a[1]) + (a[2] * a[2] + a[3] * a[3]) + (b[0] * b[0] + b[1] * b[1]) + (b[2] * b[2] + b[3] * b[3]); }
                q = wave_sum(q);
                const float rs = rsqrtf(q * (1.0f / DM) + 1e-6f);
#pragma unroll
                for (int j = 0; j < 4; ++j) { const int c = j * 512 + lane * 8; const f32x4 a = va[u][j] * rs, b = vb[u][j] * rs;
                    u32x4 w; w.x = pack_bf2(a[0], a[1]); w.y = pack_bf2(a[2], a[3]); w.z = pack_bf2(b[0], b[1]); w.w = pack_bf2(b[2], b[3]);
                    *(u32x4*)(XB + (size_t)row * DM + c) = w; } }
        }
    }
    if (common_role) {
        float* W1 = (float*)lds_raw; float* W2 = W1 + 33 * 64; float* W3 = W2 + 64 * 64; float* B1 = W3 + 64 * 64; float* B2 = B1 + 64; float* B3 = B2 + 64; float* FR = B3 + 64;
        for (int i = tid; i < 33 * 64; i += NTHR) W1[i] = p.in[I_FW1][i];
        for (int i = tid; i < 64 * 64; i += NTHR) { W2[i] = p.in[I_FW2][i]; W3[i] = p.in[I_FW3][i]; }
        if (tid < 64) { B1[tid] = p.in[I_FB1][tid]; B2[tid] = p.in[I_FB2][tid]; B3[tid] = p.in[I_FB3][tid]; FR[tid] = p.in[I_FREQ][tid]; }
        __syncthreads();
        bf16_t* H3 = (bf16_t*)(ws + WS_H3);
        const float fr = FR[lane] * 0.15915494309189535f;
        for (int pos = bx * 8 + wid; pos < LP + LS; pos += G * 8) {
            const int L = pos < LP ? LP : LS, n = pos < LP ? pos : pos - LP;
            float z;
            if (lane == 0) z = (float)n / (float)(L - 1);
            else {
                const int j = (lane - 1) & 15; const float f = 1e-4f + (float)j * ((15.0f - 1e-4f) / 15.0f);
                const float rev = (float)n * f / (float)L;
                z = (lane <= 16) ? __builtin_amdgcn_cosf(rev) : -__builtin_amdgcn_sinf(rev);
            }
            float a = B1[lane];
#pragma unroll
            for (int i = 0; i < 33; ++i) a += __builtin_bit_cast(float, __builtin_amdgcn_readlane(__builtin_bit_cast(int, z), i)) * W1[i * 64 + lane];
            float h = __builtin_amdgcn_sinf(fr * a);
            a = B2[lane];
#pragma unroll
            for (int i = 0; i < 64; ++i) a += __builtin_bit_cast(float, __builtin_amdgcn_readlane(__builtin_bit_cast(int, h), i)) * W2[i * 64 + lane];
            h = __builtin_amdgcn_sinf(fr * a);
            a = B3[lane];
#pragma unroll
            for (int i = 0; i < 64; ++i) a += __builtin_bit_cast(float, __builtin_amdgcn_readlane(__builtin_bit_cast(int, h), i)) * W3[i * 64 + lane];
            h = __builtin_amdgcn_sinf(fr * a);
            H3[(size_t)pos * 64 + lane] = (bf16_t)f2bf(h);
        }
        __syncthreads();
    }
    if (common_role) {
        float* tl = (float*)lds_raw + wid * (64 * 65);
        bf16_t* W1T = (bf16_t*)(ws + WS_W1T); bf16_t* WOT = (bf16_t*)(ws + WS_WOT); bf16_t* W4T = (bf16_t*)(ws + WS_W4T);
        for (int t = bx * 8 + wid; t < 32 * 96 + 32 * 32 + 64; t += G * 8) {
            if (t < 32 * 96) {
                const int kt = t & 31, ct = t >> 5; const int pc = ct * 64;
                const int row = pc < 3072 ? pc : (pc < 4096 ? 5120 + (pc - 3072) : (pc < 5120 ? 3072 + (pc - 4096) : 6144 + (pc - 5120)));
                transpose_tile(tl, p.in[I_WIN], 6144, kt * 64, pc, p.in[I_NORMG], W1T, row, DM, lane);
            } else if (t < 32 * 96 + 32 * 32) {
                const int u = t - 32 * 96, kt = u & 31, ct = u >> 5; const float* sc = kt < 16 ? p.in[I_NHY] : p.in[I_NFN] - 1024;
                transpose_tile(tl, p.in[I_WOUT], DM, kt * 64, ct * 64, sc, WOT, ct * 64, DM, lane);
            } else { const int u = t - 32 * 96 - 32 * 32; transpose_tile(tl, p.in[I_FW4], 4096, 0, u * 64, nullptr, W4T, u * 64, 64, lane); }
        }
        __syncthreads();
    }
    {
        float2* fl = (float2*)lds_raw; float* TF = (float*)(ws + WS_TF);
        for (int t = bx0; tf_role && t < 16; t += (NTF ? NTF : G0)) {
            const int g = t >> 2, d0 = (t & 3) * 64;
            for (int e = tid; e < 16384; e += NTHR) { const int i = e & 63, f = e >> 6; fl[LPAD(i * 256 + f)] = make_float2(p.in[I_FNW][((size_t)g * 256 + f) * 256 + d0 + i], 0.f); }
            __syncthreads();
            fft_pass<4, 4, false>(fl, tid); __syncthreads();
            fft_pass<4, 0, false>(fl, tid); __syncthreads();
            for (int e = tid; e < 16384; e += NTHR) { const int i = e & 63, c = e >> 6; const float2 v = fl[LPAD(i * 256 + (int)brev(c, 8))];
                TF[(((size_t)g * 2 + 0) * 256 + c) * 256 + d0 + i] = v.x; TF[(((size_t)g * 2 + 1) * 256 + c) * 256 + d0 + i] = v.y; }
            { bf16_t* B1 = (bf16_t*)(ws + WS_BMIX); bf16_t* B2 = B1 + 4 * 256 * 512;
              for (int e = tid; e < 16384; e += NTHR) { const int c = e & 255, i = e >> 8; const float2 v = fl[LPAD(i * 256 + (int)brev(c, 8))];
                  const size_t o = ((size_t)g * 256 + d0 + i) * 512 + c;
                  B1[o] = (bf16_t)f2bf(v.x); B1[o + 256] = (bf16_t)f2bf(-v.y); B2[o] = (bf16_t)f2bf(v.x); B2[o + 256] = (bf16_t)f2bf(v.y); } }
            __syncthreads();
        }
    }
}

DV void h_gemm(const Params& p, unsigned char* lds_raw, _Float16* H, int pos0, int L) {
    const int tid = threadIdx.x, lane = tid & 63, wid = tid >> 6, G = gridDim.x;
    const bf16_t* H3 = (const bf16_t*)(p.ws + WS_H3) + (size_t)pos0 * 64; const bf16_t* W4T = (const bf16_t*)(p.ws + WS_W4T);
    unsigned char* wl = lds_raw + wid * 4608;
    const int ntg = L / 512, ntask = 128 * ntg;
    const int r = lane & 31, hh = lane >> 5;
    for (int task = blockIdx.x * 8 + wid; task < ntask; task += G * 8) {
        const int ct = task / ntg, tg = task % ntg;
        bf16x8 bf[4];
#pragma unroll
        for (int s = 0; s < 4; ++s) bf[s] = *(const bf16x8*)(W4T + (size_t)(ct * 32 + r) * 64 + 16 * s + 8 * hh);
        const int c = (ct * 32 + r) & 127;
        const float delta = -3.0701134573253946f + (-15.350567286626973f + 3.0701134573253946f) * ((float)c * (1.0f / 127.0f));
        const float dl = -fabsf(delta) * (1.0f / (float)(L - 1));
        bf16x8 afc[2][4];
#pragma unroll
        for (int w = 0; w < 2; ++w)
#pragma unroll
            for (int s = 0; s < 4; ++s) afc[w][s] = *(const bf16x8*)(H3 + (size_t)(tg * 512 + 32 * w + r) * 64 + 16 * s + 8 * hh);
        for (int tt = 0; tt < 8; ++tt) {
            const int t0 = tg * 512 + tt * 64;
            const int tn = tg * 512 + (tt < 7 ? tt + 1 : tt) * 64;
            bf16x8 afn[2][4];
#pragma unroll
            for (int w = 0; w < 2; ++w)
#pragma unroll
                for (int s = 0; s < 4; ++s) afn[w][s] = *(const bf16x8*)(H3 + (size_t)(tn + 32 * w + r) * 64 + 16 * s + 8 * hh);
#pragma unroll
            for (int w = 0; w < 2; ++w) {
                f32x16 acc;
#pragma unroll
                for (int i = 0; i < 16; ++i) acc[i] = 0.f;
#pragma unroll
                for (int s = 0; s < 4; ++s) acc = __builtin_amdgcn_mfma_f32_32x32x16_bf16(afc[w][s], bf[s], acc, 0, 0, 0);
#pragma unroll
                for (int g = 0; g < 4; ++g) {
                    const int tl = 32 * w + 8 * g + 4 * hh; float v[4];
#pragma unroll
                    for (int e = 0; e < 4; ++e) v[e] = acc[4 * g + e] * __expf(dl * (float)(t0 + tl + e)) * 256.0f;
                    u32x2 pk; pk.x = pack_h2(v[0], v[1]); pk.y = pack_h2(v[2], v[3]);
                    *(u32x2*)(wl + r * 144 + tl * 2) = pk;
                }
            }
            asm volatile("s_waitcnt lgkmcnt(0)" ::: "memory"); __builtin_amdgcn_wave_barrier();
#pragma unroll
            for (int q = 0; q < 4; ++q) {
                const int col = q * 8 + (lane >> 3), ch = lane & 7;
                const u32x4 v = *(const u32x4*)(wl + col * 144 + ch * 16);
                *(u32x4*)(H + (size_t)(ct * 32 + col) * L + t0 + ch * 8) = v;
            }
            asm volatile("s_waitcnt lgkmcnt(0)" ::: "memory"); __builtin_amdgcn_wave_barrier();
#pragma unroll
            for (int w = 0; w < 2; ++w)
#pragma unroll
                for (int s = 0; s < 4; ++s) afc[w][s] = afn[w][s];
        }
    }
    __syncthreads();
}
DV void wfold_gemm(const Params& p) {
    const int tid = threadIdx.x, lane = tid & 63, wid = tid >> 6, G = gridDim.x;
    const float* TF = (const float*)(p.ws + WS_TF); bf16_t* W1T = (bf16_t*)(p.ws + WS_W1T);
    const int r = lane & 31, hh = lane >> 5;
    for (int task = blockIdx.x * 8 + wid; task < 4096; task += G * 8) {
        const int kt = task & 63, dt = (task >> 6) & 15, g = task >> 10; const int part = dt >> 3, d0 = (dt & 7) * 32;
        const float* ap = TF + (((size_t)g * 2 + part) * 256 + hh) * 256 + d0 + r;
        const int k = kt * 32 + r;
        const float* bp = (const float*)(p.ws + WS_WFT) + (size_t)(g * 256 + hh) * DM + k;
        f32x16 acc;
#pragma unroll
        for (int i = 0; i < 16; ++i) acc[i] = 0.f;
#pragma unroll 8
        for (int c0 = 0; c0 < 256; c0 += 2) acc = __builtin_amdgcn_mfma_f32_32x32x2f32(ap[(size_t)c0 * 256], bp[(size_t)c0 * DM], acc, 0, 0, 0);
#pragma unroll
        for (int i = 0; i < 16; ++i) { const int row = (i & 3) + 8 * (i >> 2) + 4 * hh;
            W1T[(size_t)(3072 + part * 1024 + g * 256 + d0 + row) * DM + k] = (bf16_t)f2bf(acc[i]); }
    }
}

struct KfRaw { u32x4 a0, a1, b0, b1; _Float16 nxt; };
template <int NB> DV void kf_load(const Params& p, const _Float16* H, int task, int tid, KfRaw (&raw)[2]) {
    constexpr int L = 1 << NB, NSEQ = (NB == 14) ? 1 : 2;
#pragma unroll
    for (int u = 0; u < 2; ++u) {
        const int ch = tid + u * NTHR, q = ch / (L / 16), j = ch % (L / 16);
        const int row = task * NSEQ + q, o = row >> 10, c = row & 1023;
        const _Float16* hf = H + (size_t)((o * 2 + 0) * 1024 + c) * L; const _Float16* hb = H + (size_t)((o * 2 + 1) * 1024 + c) * L;
        raw[u].a0 = ldnt4(hf + 16 * j); raw[u].a1 = ldnt4(hf + 16 * j + 8);
        raw[u].b0 = ldnt4(hb + 16 * j); raw[u].b1 = ldnt4(hb + 16 * j + 8);
        raw[u].nxt = (16 * j + 16 < L) ? hb[16 * j + 16] : (_Float16)0.f;
    }
}
template <int NB> DV void kf_phase(const Params& p, float2* fl, const _Float16* H, uint2* KF) {
    constexpr int L = 1 << NB, NSEQ = (NB == 14) ? 1 : 2, SLOTS = L / 2;
    static_assert((NSEQ * (L / 16)) / NTHR == 2, "chunk geometry");
    const int tid = threadIdx.x, G = gridDim.x;
    KfRaw raw[2];
    if ((int)blockIdx.x < 2048 / NSEQ) kf_load<NB>(p, H, blockIdx.x, tid, raw);
    for (int task = blockIdx.x; task < 2048 / NSEQ; task += G) {
#pragma unroll
        for (int u = 0; u < 2; ++u) {
            const int ch = tid + u * NTHR, q = ch / (L / 16), j = ch % (L / 16);
            const int row = task * NSEQ + q, o = row >> 10, c = row & 1023;
            const float skip = p.in[I_SKIP][o * 1024 + c];
            const int base = q * L;
            const unsigned aw[8] = {raw[u].a0.x, raw[u].a0.y, raw[u].a0.z, raw[u].a0.w, raw[u].a1.x, raw[u].a1.y, raw[u].a1.z, raw[u].a1.w};
#pragma unroll
            for (int e = 0; e < 8; ++e) { float x = h_lo(aw[e]) * (1.0f / 256.0f), y = h_hi(aw[e]) * (1.0f / 256.0f); if (j == 0 && e == 0) x += skip; fl[LPAD(base + 8 * j + e)] = make_float2(x, y); }
            const unsigned bw[8] = {raw[u].b0.x, raw[u].b0.y, raw[u].b0.z, raw[u].b0.w, raw[u].b1.x, raw[u].b1.y, raw[u].b1.z, raw[u].b1.w};
            const float nxt = (float)raw[u].nxt * (1.0f / 256.0f);
#pragma unroll
            for (int a = 0; a < 8; ++a) { const float y = h_hi(bw[a]) * (1.0f / 256.0f); const float x = (a < 7) ? h_lo(bw[a + 1]) * (1.0f / 256.0f) : nxt;
                fl[LPAD(base + L - 8 * j - 1 - a)] = make_float2(x, y); }
        }
        __syncthreads();
        if (NB == 14) { fft_pass<5, 9, false>(fl, tid); __syncthreads(); fft_pass<5, 4, false>(fl, tid); __syncthreads(); }
        else { fft_pass<5, 8, false>(fl, tid); __syncthreads(); fft_pass<4, 4, false>(fl, tid); __syncthreads(); }
        kf_load<NB>(p, H, (task + G < 2048 / NSEQ) ? task + G : task, tid, raw);
        kf_mid<NB, NSEQ>(fl, tid, KF + (size_t)(task * NSEQ) * SLOTS, KF + (size_t)(task * NSEQ + NSEQ - 1) * SLOTS);
        __syncthreads();
    }
}

template <int NB> DV void fft_fwd(float2* fl, int tid) {
    if (NB == 14) { fft_pass<5, 9, false>(fl, tid); __syncthreads(); fft_pass<5, 4, false>(fl, tid); __syncthreads(); fft_pass<4, 0, false>(fl, tid); __syncthreads(); }
    else { fft_pass<5, 8, false>(fl, tid); __syncthreads(); fft_pass<4, 4, false>(fl, tid); __syncthreads(); fft_pass<4, 0, false>(fl, tid); __syncthreads(); }
}
template <int NB> DV void fft_inv(float2* fl, int tid) {
    if (NB == 14) { fft_pass<4, 0, true>(fl, tid); __syncthreads(); fft_pass<5, 4, true>(fl, tid); __syncthreads(); fft_pass<5, 9, true>(fl, tid); __syncthreads(); }
    else { fft_pass<4, 0, true>(fl, tid); __syncthreads(); fft_pass<4, 4, true>(fl, tid); __syncthreads(); fft_pass<5, 8, true>(fl, tid); __syncthreads(); }
}
template <int NB> DV void fft_fwd_zh(float2* fl, int tid) {
    if (NB == 14) { fft_pass<5, 9, false, true>(fl, tid); __syncthreads(); fft_pass<5, 4, false>(fl, tid); __syncthreads(); fft_pass<4, 0, false>(fl, tid); __syncthreads(); }
    else { fft_pass<5, 8, false, true>(fl, tid); __syncthreads(); fft_pass<4, 4, false>(fl, tid); __syncthreads(); fft_pass<4, 0, false>(fl, tid); __syncthreads(); }
}
template <int NB> DV void fft_inv_lh(float2* fl, int tid) {
    if (NB == 14) { fft_pass<4, 0, true>(fl, tid); __syncthreads(); fft_pass<5, 4, true>(fl, tid); __syncthreads(); fft_pass<5, 9, true, true>(fl, tid); __syncthreads(); }
    else { fft_pass<4, 0, true>(fl, tid); __syncthreads(); fft_pass<4, 4, true>(fl, tid); __syncthreads(); fft_pass<5, 8, true, true>(fl, tid); __syncthreads(); }
}

struct ScRaw { u32x4 a0, a1; unsigned short lo, hi; };
DV ScRaw sc_load(const bf16_t* rowp  , int tl, int L) {
    ScRaw r; r.a0 = ldnt4(rowp + tl); r.a1 = ldnt4(rowp + tl + 8);
    r.lo = tl > 0 ? rowp[tl - 1] : (unsigned short)0; r.hi = (tl + 16 < L) ? rowp[tl + 16] : (unsigned short)0; return r;
}
DV void sc_compute(const ScRaw& r, float w0, float w1, float w2, float b, float (&v)[16]) {
    const unsigned aw[8] = {r.a0.x, r.a0.y, r.a0.z, r.a0.w, r.a1.x, r.a1.y, r.a1.z, r.a1.w};
    float u[18];
    u[0] = bf2f(r.lo); u[17] = bf2f(r.hi);
#pragma unroll
    for (int e = 0; e < 8; ++e) { u[1 + 2 * e] = bf2f(aw[e] & 0xffffu); u[2 + 2 * e] = bf2f(aw[e] >> 16); }
#pragma unroll
    for (int e = 0; e < 16; ++e) v[e] = u[e] * w0 + u[e + 1] * w1 + u[e + 2] * w2 + b;
}
DV void short_conv16(const bf16_t* rowp, int tl, int L, float w0, float w1, float w2, float b, float (&v)[16]) { const ScRaw r = sc_load(rowp, tl, L); sc_compute(r, w0, w1, w2, b, v); }

template <int NB> DV void hy_vload(const Params& p, int c, int tok0, int tid, ScRaw (&vraw)[2]) {
    constexpr int L = 1 << NB;
    const bf16_t* PT = (const bf16_t*)(p.ws + WS_B);
#pragma unroll
    for (int u = 0; u < 2; ++u) { const int ch = tid + u * NTHR, q = ch / (L / 16), j = ch % (L / 16); vraw[u] = sc_load(PT + (size_t)(2048 + c) * NTOK + tok0 + q * L, 16 * j, L); }
}
template <int NB> DV void hyena_task(const Params& p, float2* fl, int c, const uint2* KF, int tok0, ScRaw (&vraw)[2], int c_next) {
    constexpr int L = 1 << NB, NSEQ = (NB == 14) ? 1 : 2, SLOTS = L / 2;
    constexpr int NCH = (NSEQ * (L / 16)) / NTHR;
    static_assert(NCH == 2, "chunk geometry");
    int tid = threadIdx.x; asm volatile("" : "+v"(tid));
    bf16_t* PT = (bf16_t*)(p.ws + WS_B);
    const float* cw = p.in[I_CONVW]; const float* cb = p.in[I_CONVB];
    {
        const int col = 2048 + c;
        const float w0 = cw[col], w1 = cw[3072 + col], w2 = cw[6144 + col], b = cb[col];
#pragma unroll
        for (int u = 0; u < NCH; ++u) {
            const int ch = tid + u * NTHR, q = ch / (L / 16), j = ch % (L / 16);
            float v[16]; sc_compute(vraw[u], w0, w1, w2, b, v);
#pragma unroll
            for (int e = 0; e < 8; ++e) fl[LPAD(q * L + 8 * j + e)] = make_float2(v[2 * e], v[2 * e + 1]);
        }
    }
    __syncthreads();
    ScRaw raw[NCH];
    float w0 = 0.f, w1 = 0.f, w2 = 0.f, b = 0.f;
#pragma unroll 1
    for (int o = 0; o < 2; ++o) {
        if (NB == 14) { fft_pass<5, 9, false, true>(fl, tid); __syncthreads(); } else { fft_pass<5, 8, false, true>(fl, tid); __syncthreads(); }
        uint2 slots[16];
        kf_prefetch<NB, NSEQ>(KF + (size_t)(o * 1024 + c) * SLOTS, tid, slots);
        if (NB == 14) { fft_pass<5, 4, false>(fl, tid); __syncthreads(); } else { fft_pass<4, 4, false>(fl, tid); __syncthreads(); }
        conv_mid<NB, NSEQ>(fl, tid, slots);
        __syncthreads();
        if (NB == 14) { fft_pass<5, 4, true>(fl, tid); __syncthreads(); }
        else { fft_pass<4, 4, true>(fl, tid); __syncthreads(); }
        asm volatile("" : "+v"(tid));
        const int col = o * 1024 + c;
        w0 = cw[col]; w1 = cw[3072 + col]; w2 = cw[6144 + col]; b = cb[col];
#pragma unroll
        for (int u = 0; u < NCH; ++u) { const int ch = tid + u * NTHR, q = ch / (L / 16), j = ch % (L / 16); raw[u] = sc_load(PT + (size_t)col * NTOK + tok0 + q * L, 16 * j, L); }
        if (NB == 14) fft_pass<5, 9, true, true>(fl, tid); else fft_pass<5, 8, true, true>(fl, tid);
        __syncthreads();
        if (o == 1) break;
#pragma unroll
        for (int u = 0; u < NCH; ++u) {
            const int ch = tid + u * NTHR, q = ch / (L / 16), j = ch % (L / 16);
            float v[16]; sc_compute(raw[u], w0, w1, w2, b, v);
#pragma unroll
            for (int e = 0; e < 8; ++e) { const float2 z = fl[LPAD(q * L + 8 * j + e)]; fl[LPAD(q * L + 8 * j + e)] = make_float2(z.x * v[2 * e], z.y * v[2 * e + 1]); }
        }
        __syncthreads();
    }
    if (NB == 14) hy_vload<13>(p, c_next, LP, tid, vraw); else hy_vload<14>(p, c_next, 0, tid, vraw);
#pragma unroll
    for (int u = 0; u < NCH; ++u) {
        const int ch = tid + u * NTHR, q = ch / (L / 16), j = ch % (L / 16);
        bf16_t* op = PT + (size_t)(2048 + c) * NTOK + tok0 + q * L;
        float v[16]; sc_compute(raw[u], w0, w1, w2, b, v);
        float y[16];
#pragma unroll
        for (int e = 0; e < 8; ++e) { const float2 z = fl[LPAD(q * L + 8 * j + e)]; y[2 * e] = z.x * v[2 * e]; y[2 * e + 1] = z.y * v[2 * e + 1]; }
        u32x4 w0v, w1v;
        w0v.x = pack_bf2(y[0], y[1]); w0v.y = pack_bf2(y[2], y[3]); w0v.z = pack_bf2(y[4], y[5]); w0v.w = pack_bf2(y[6], y[7]);
        w1v.x = pack_bf2(y[8], y[9]); w1v.y = pack_bf2(y[10], y[11]); w1v.z = pack_bf2(y[12], y[13]); w1v.w = pack_bf2(y[14], y[15]);
        *(u32x4*)(op + 16 * j) = w0v; *(u32x4*)(op + 16 * j + 8) = w1v;
    }
    __syncthreads();
}
template <int NB> DV void fnet_task(const Params& p, float2* fl, int j, int tok0) {
    constexpr int L = 1 << NB, NSEQ = (NB == 14) ? 1 : 2;
    int tid = threadIdx.x; asm volatile("" : "+v"(tid));
    bf16_t* PT = (bf16_t*)(p.ws + WS_B);
    const float bias = p.in[I_FNB][j]; const float scale = 1.0f / sqrtf((float)L * 256.0f);
#pragma unroll
    for (int q = 0; q < NSEQ; ++q) {
        const bf16_t* rr = PT + (size_t)(3072 + j) * NTOK + tok0 + q * L; const bf16_t* ri = PT + (size_t)(4096 + j) * NTOK + tok0 + q * L;
        for (int t = tid; t < L / 8; t += NTHR) {
            const u32x4 a = *(const u32x4*)(rr + 8 * t), b = *(const u32x4*)(ri + 8 * t);
            const unsigned aw[4] = {a.x, a.y, a.z, a.w}, bw[4] = {b.x, b.y, b.z, b.w};
#pragma unroll
            for (int e = 0; e < 4; ++e) {
                fl[LPAD(q * L + (int)brev(8 * t + 2 * e, NB))] = make_float2(bf2f(aw[e] & 0xffffu), -bf2f(bw[e] & 0xffffu));
                fl[LPAD(q * L + (int)brev(8 * t + 2 * e + 1, NB))] = make_float2(bf2f(aw[e] >> 16), -bf2f(bw[e] >> 16));
            }
        }
    }
    __syncthreads();
    fft_inv<NB>(fl, tid);
#pragma unroll
    for (int q = 0; q < NSEQ; ++q) {
        bf16_t* op = PT + (size_t)(3072 + j) * NTOK + tok0 + q * L;
        for (int t = tid; t < L / 8; t += NTHR) {
            float y[8];
#pragma unroll
            for (int e = 0; e < 8; ++e) y[e] = fl[LPAD(q * L + 8 * t + e)].x * scale + bias;
            u32x4 w; w.x = pack_bf2(y[0], y[1]); w.y = pack_bf2(y[2], y[3]); w.z = pack_bf2(y[4], y[5]); w.w = pack_bf2(y[6], y[7]);
            *(u32x4*)(op + 8 * t) = w;
        }
    }
    __syncthreads();
}


template <int NB> DV void fnet2_task(const Params& p, float2* fl, int pr, int tok0, int rowbase) {
    constexpr int L = 1 << NB, NSEQ = (NB == 14) ? 1 : 2, IB = NB - 10, HN = L / 2;
    int tid = threadIdx.x; asm volatile("" : "+v"(tid));
    bf16_t* PT = (bf16_t*)(p.ws + WS_B);
    bf16_t* UR = PT + (size_t)4096 * NTOK; bf16_t* UI = UR + (size_t)1024 * 16384;
    float* NYQ = (float*)(p.ws + WS_NYQ);
#pragma unroll
    for (int q = 0; q < NSEQ; ++q) {
        const bf16_t* ra = PT + (size_t)(3072 + 2 * pr) * NTOK + tok0 + q * L; const bf16_t* rb = ra + NTOK;
        for (int t = tid; t < L / 8; t += NTHR) {
            const u32x4 a = ldnt4(ra + 8 * t), b = ldnt4(rb + 8 * t);
            const unsigned aw[4] = {a.x, a.y, a.z, a.w}, bw[4] = {b.x, b.y, b.z, b.w};
#pragma unroll
            for (int e = 0; e < 4; ++e) {
                fl[LPAD(q * L + 8 * t + 2 * e)] = make_float2(bf2f(aw[e] & 0xffffu), bf2f(bw[e] & 0xffffu));
                fl[LPAD(q * L + 8 * t + 2 * e + 1)] = make_float2(bf2f(aw[e] >> 16), bf2f(bw[e] >> 16));
            }
        }
    }
    __syncthreads();
    fft_fwd<NB>(fl, tid);
    asm volatile("" : "+v"(tid));
    v2f ua[NSEQ][1 << IB], ub[NSEQ][1 << IB];
#pragma unroll
    for (int i = 0; i < (1 << IB); ++i) {
        const int k = pair_k<NB>(tid, i);
#pragma unroll
        for (int q = 0; q < NSEQ; ++q) {
            const int base = q * L;
            if (k == 0) {
                const float2 z0 = fl[LPAD(base)], zh = fl[LPAD(base + 1)];
                ua[q][i] = (v2f){z0.x, 0.f}; ub[q][i] = (v2f){z0.y, 0.f};
                const int seq = (NB == 14) ? 0 : 1 + q;
                NYQ[seq * 1024 + 2 * pr] = zh.x; NYQ[seq * 1024 + 2 * pr + 1] = zh.y;
            } else {
                const float2 zk = fl[LPAD(base + (int)brev(k, NB))], zn = fl[LPAD(base + (int)brev(L - k, NB))];
                ua[q][i] = (v2f){0.5f * (zk.x + zn.x), 0.5f * (zk.y - zn.y)};
                ub[q][i] = (v2f){0.5f * (zk.y + zn.y), -0.5f * (zk.x - zn.x)};
            }
        }
    }
    __syncthreads();
#pragma unroll
    for (int i = 0; i < (1 << IB); ++i) {
        const int k = pair_k<NB>(tid, i);
#pragma unroll
        for (int q = 0; q < NSEQ; ++q) { ((v2f*)fl)[LPAD(q * L + k)] = ua[q][i]; ((v2f*)fl)[LPAD(q * L + HN + k)] = ub[q][i]; }
    }
    __syncthreads();
#pragma unroll
    for (int q = 0; q < NSEQ; ++q)
#pragma unroll
        for (int ch = 0; ch < 2; ++ch) {
            const size_t ro = (size_t)(2 * pr + ch) * 16384 + rowbase + q * HN;
            for (int t = tid; t < HN / 8; t += NTHR) {
                float2 z[8];
#pragma unroll
                for (int e = 0; e < 8; ++e) z[e] = fl[LPAD(q * L + ch * HN + 8 * t + e)];
                u32x4 wr_, wi_;
                wr_.x = pack_bf2(z[0].x, z[1].x); wr_.y = pack_bf2(z[2].x, z[3].x); wr_.z = pack_bf2(z[4].x, z[5].x); wr_.w = pack_bf2(z[6].x, z[7].x);
                wi_.x = pack_bf2(z[0].y, z[1].y); wi_.y = pack_bf2(z[2].y, z[3].y); wi_.z = pack_bf2(z[4].y, z[5].y); wi_.w = pack_bf2(z[6].y, z[7].y);
                *(u32x4*)(UR + ro + 8 * t) = wr_; *(u32x4*)(UI + ro + 8 * t) = wi_;
            }
        }
    __syncthreads();
}
DV void utrans_phase(const Params& p, unsigned char* lds_raw) {
    const int tid = threadIdx.x, lane = tid & 63, wid = tid >> 6, G = gridDim.x;
    unsigned* tl = (unsigned*)lds_raw;
    const bf16_t* PT = (const bf16_t*)(p.ws + WS_B);
    const bf16_t* UR = PT + (size_t)4096 * NTOK; const bf16_t* UI = UR + (size_t)1024 * 16384;
    bf16_t* AG = (bf16_t*)(p.ws + WS_B) + (size_t)1024 * NTOK;
    for (int item = blockIdx.x; item < 512; item += G) {
        const int plane = item & 1, r0 = (item >> 1) * 64; const bf16_t* src = plane ? UI : UR;
#pragma unroll
        for (int it = 0; it < 8; ++it) {
            const int id = it * NTHR + tid, q = id & 7, cp = id >> 3;
            const bf16_t* ra = src + (size_t)(2 * cp) * 16384 + r0 + 8 * q;
            const u32x4 a = ldnt4(ra), b = ldnt4(ra + 16384);
            const unsigned aw[4] = {a.x, a.y, a.z, a.w}, bw[4] = {b.x, b.y, b.z, b.w};
            const int pc = cp ^ (q << 2);
#pragma unroll
            for (int e = 0; e < 4; ++e) {
                tl[(8 * q + 2 * e) * 512 + pc] = (aw[e] & 0xffffu) | (bw[e] << 16);
                tl[(8 * q + 2 * e + 1) * 512 + pc] = (aw[e] >> 16) | (bw[e] & 0xffff0000u);
            }
        }
        __syncthreads();
#pragma unroll
        for (int tk = 0; tk < 8; ++tk) {
            const int tok = wid * 8 + tk;
#pragma unroll
            for (int j = 0; j < 2; ++j) {
                const int g4 = lane + 64 * j, g = g4 >> 5, cl = (8 * g4) & 255;
                const u32x4 d = *(const u32x4*)(tl + tok * 512 + 4 * (g4 ^ wid));
                *(u32x4*)(AG + ((size_t)g * 16384 + r0 + tok) * 512 + plane * 256 + cl) = d;
            }
        }
        __syncthreads();
    }
}
DV void nyquist_fix(const Params& p) {
    const float* NYQ = (const float*)(p.ws + WS_NYQ); const float* TF = (const float*)(p.ws + WS_TF);
    bf16_t* YG = (bf16_t*)(p.ws + WS_B);
    for (int o = blockIdx.x * NTHR + threadIdx.x; o < 3072; o += gridDim.x * NTHR) {
        const int seq = o >> 10, col = o & 1023, g = col >> 8, d = col & 255;
        float acc = 0.f;
        for (int c = 0; c < 256; ++c) acc += NYQ[seq * 1024 + g * 256 + c] * TF[(((size_t)g * 2 + 0) * 256 + c) * 256 + d];
        const int L = seq == 0 ? LP : LS, tok0 = seq == 0 ? 0 : LP + (seq - 1) * LS;
        const float scale = seq == 0 ? (1.0f / 2048.0f) : 0.00069053396600248786f;
        YG[(size_t)(tok0 + L / 2) * 1024 + col] = (bf16_t)f2bf(acc * scale + p.in[I_FNB][col]);
    }
}

DV void gate_phase(const Params& p, unsigned char* lds_raw) {
    const int tid = threadIdx.x, lane = tid & 63, wid = tid >> 6, G = gridDim.x;
    unsigned* tl = (unsigned*)lds_raw;
    const bf16_t* PT = (const bf16_t*)(p.ws + WS_B);
    const unsigned* ZT = (const unsigned*)((const unsigned char*)p.out + OUT_ZT); unsigned* T = (unsigned*)(p.ws + WS_A);
    for (int item = blockIdx.x; item < 1024; item += G) {
        const int half = item & 1, m0 = (item >> 1) * 64;
        const unsigned* YG = (const unsigned*)(p.ws + WS_B);
        u32x4 zt[8][2];
#pragma unroll
        for (int tk = 0; tk < 8; ++tk)
#pragma unroll
            for (int j = 0; j < 2; ++j) zt[tk][j] = ldnt4(ZT + (size_t)(m0 + wid * 8 + tk) * 1024 + half * 512 + 4 * (lane + 64 * j));
        if (half == 0)
#pragma unroll
        for (int it = 0; it < 8; ++it) {
            const int id = it * NTHR + tid, q = id & 7, cp = id >> 3;
            const bf16_t* ra = PT + (size_t)(2048 + half * 1024 + 2 * cp) * NTOK + m0 + 8 * q;
            const u32x4 a = ldnt4(ra), b = ldnt4(ra + NTOK);
            const unsigned aw[4] = {a.x, a.y, a.z, a.w}, bw[4] = {b.x, b.y, b.z, b.w};
            const int pc = cp ^ (q << 2);
#pragma unroll
            for (int e = 0; e < 4; ++e) {
                tl[(8 * q + 2 * e) * 512 + pc] = (aw[e] & 0xffffu) | (bw[e] << 16);
                tl[(8 * q + 2 * e + 1) * 512 + pc] = (aw[e] >> 16) | (bw[e] & 0xffff0000u);
            }
        }
        __syncthreads();
#pragma unroll
        for (int tk = 0; tk < 8; ++tk) {
            const int tok = wid * 8 + tk; const size_t mrow = (size_t)(m0 + tok) * 1024 + half * 512;
            float pr[16]; float q = 0.f;
#pragma unroll
            for (int j = 0; j < 2; ++j) {
                const int g4 = lane + 64 * j;
                const u32x4 d = half ? ldnt4(YG + (size_t)(m0 + tok) * 512 + 4 * g4) : *(const u32x4*)(tl + tok * 512 + 4 * (g4 ^ wid)), z = zt[tk][j];
                const unsigned dw[4] = {d.x, d.y, d.z, d.w}, zw[4] = {z.x, z.y, z.z, z.w};
#pragma unroll
                for (int e = 0; e < 4; ++e) { const float v0 = bf2f(dw[e] & 0xffffu) * pg8::silu_f(bf2f(zw[e] & 0xffffu)), v1 = bf2f(dw[e] >> 16) * pg8::silu_f(bf2f(zw[e] >> 16));
                    pr[8 * j + 2 * e] = v0; pr[8 * j + 2 * e + 1] = v1; q += v0 * v0 + v1 * v1; }
            }
            q = wave_sum(q);
            const float rs = rsqrtf(q * (1.0f / 1024.0f) + 1e-6f);
#pragma unroll
            for (int j = 0; j < 2; ++j) {
                u32x4 o; o.x = pack_bf2(pr[8 * j] * rs, pr[8 * j + 1] * rs); o.y = pack_bf2(pr[8 * j + 2] * rs, pr[8 * j + 3] * rs);
                o.z = pack_bf2(pr[8 * j + 4] * rs, pr[8 * j + 5] * rs); o.w = pack_bf2(pr[8 * j + 6] * rs, pr[8 * j + 7] * rs);
                *(u32x4*)(T + mrow + 4 * (lane + 64 * j)) = o;
            }
        }
        __syncthreads();
    }
}
DV void final_phase(const Params& p) {
    const int tid = threadIdx.x, lane = tid & 63, wid = tid >> 6, G = gridDim.x;
    const bf16_t* Y = (const bf16_t*)(p.ws + WS_B); const float* fn = p.in[I_FNORM];
    for (int row0 = blockIdx.x * 8 + wid; row0 < NTOK; row0 += 2 * G * 8) {
        u32x4 yv[2][4]; f32x4 xa[2][4], xb[2][4];
#pragma unroll
        for (int u = 0; u < 2; ++u) { const int row = (row0 + u * G * 8 < NTOK) ? row0 + u * G * 8 : row0;
            const float* xr = row < LP ? p.in[I_XP] + (size_t)row * DM : p.in[I_XS] + (size_t)(row - LP) * DM;
#pragma unroll
            for (int j = 0; j < 4; ++j) { const int c = j * 512 + lane * 8; yv[u][j] = __builtin_nontemporal_load((const u32x4*)(Y + (size_t)row * DM + c)); xa[u][j] = __builtin_nontemporal_load((const f32x4*)(xr + c)); xb[u][j] = __builtin_nontemporal_load((const f32x4*)(xr + c + 4)); } }
#pragma unroll
        for (int u = 0; u < 2; ++u) { const int row = row0 + u * G * 8; if (row >= NTOK) continue;
            float r[32]; float q = 0.f;
#pragma unroll
            for (int j = 0; j < 4; ++j) { const u32x4 y = yv[u][j]; const f32x4 a = xa[u][j], b = xb[u][j];
                r[8 * j + 0] = a[0] + bf2f(y.x & 0xffffu); r[8 * j + 1] = a[1] + bf2f(y.x >> 16); r[8 * j + 2] = a[2] + bf2f(y.y & 0xffffu); r[8 * j + 3] = a[3] + bf2f(y.y >> 16);
                r[8 * j + 4] = b[0] + bf2f(y.z & 0xffffu); r[8 * j + 5] = b[1] + bf2f(y.z >> 16); r[8 * j + 6] = b[2] + bf2f(y.w & 0xffffu); r[8 * j + 7] = b[3] + bf2f(y.w >> 16);
#pragma unroll
                for (int e = 0; e < 8; ++e) q += r[8 * j + e] * r[8 * j + e]; }
            q = wave_sum(q);
            const float s = rsqrtf(q * (1.0f / DM) + 1e-6f);
            float* o = p.out + (size_t)row * DM;
#pragma unroll
            for (int j = 0; j < 4; ++j) {
                const int c = j * 512 + lane * 8; const f32x4 g0 = *(const f32x4*)(fn + c), g1 = *(const f32x4*)(fn + c + 4);
                f32x4 v0, v1;
#pragma unroll
                for (int e = 0; e < 4; ++e) { v0[e] = r[8 * j + e] * s * g0[e]; v1[e] = r[8 * j + 4 + e] * s * g1[e]; }
                __builtin_nontemporal_store(v0, (f32x4*)(o + c)); __builtin_nontemporal_store(v1, (f32x4*)(o + c + 4)); } }
    }
}

DV void mix_phase(const Params& p, unsigned char* lds_raw) {
    unsigned char* ws = p.ws; const int G = gridDim.x, bx = blockIdx.x;
    const bf16_t* AG = (const bf16_t*)(ws + WS_B) + (size_t)1024 * NTOK; const bf16_t* B1 = (const bf16_t*)(ws + WS_BMIX); const bf16_t* B2 = B1 + 4 * 256 * 512;
#pragma unroll 1
    for (int j = 0; j < 8; ++j) { const int g = j >> 1, mir = j & 1;
        pg8::Gemm gm{AG + (size_t)g * 16384 * 512, (mir ? B2 : B1) + (size_t)g * 256 * 512, 16384, 256, 512};
        pg8::StaticOrder S; S.init(16384, 256, G, (bx + 8 * G - 64 * j) % G);
        pg8::EpiMix E{(bf16_t*)(ws + WS_B), p.in[I_FNB], g, mir};
        pg8::gemm_phase<pg8::EpiMix>((LAS unsigned char*)lds_raw, gm, S, E); }
    nyquist_fix(p);
}

__global__ void __launch_bounds__(NTHR, 2) mega(Params p) {
    extern __shared__ __attribute__((aligned(16))) unsigned char lds_raw[];
    float2* fl = (float2*)lds_raw;
    const int lo = p.ph_lo, hi = p.ph_hi, G = gridDim.x, bx = blockIdx.x;
    unsigned char* ws = p.ws;
#ifndef PH_MASK
#define PH_MASK 0x7ff
#endif
#define IN(k) (((PH_MASK >> (k)) & 1) && lo <= (k) && (k) < hi)
#define SEAM(k) do { if (IN(k) && IN((k) + 1)) xcd_barrier(bar); } while (0)
    XcdBarrier bar; bar.bar = (unsigned*)(ws + WS_BAR); bar.x = 0; bar.st = (volatile LAS unsigned*)((LAS unsigned char*)lds_raw + (LDS_BYTES - 16));
    if (hi - lo > 1) {
        if (threadIdx.x < 2) bar.st[threadIdx.x] = 0u;
        __syncthreads();
        bar = xcd_barrier_post((unsigned*)(ws + WS_BAR), bar.st);
    }
    if (lo < 0) cg::this_grid().sync();
#define PHASE(k, ...) do { if (IN(k)) { __VA_ARGS__ } SEAM(k); } while (0)
    PHASE(0, phase0(p, lds_raw););
    PHASE(1, h_gemm(p, lds_raw, (_Float16*)(ws + WS_B), 0, LP); h_gemm(p, lds_raw, (_Float16*)(ws + WS_B + (size_t)4096 * NTOK * 2), LP, LS););
    PHASE(2, kf_phase<14>(p, fl, (const _Float16*)(ws + WS_B), (uint2*)((unsigned char*)p.out + OUT_KFP)););
    PHASE(3,
        const bf16_t* XB = (const bf16_t*)(ws + WS_A); const bf16_t* W1T = (const bf16_t*)(ws + WS_W1T);
        { pg8::Gemm g{W1T, XB, 4096, NTOK, DM}; pg8::StaticOrder S; S.init(4096, NTOK, G, bx); pg8::EpiY E{(bf16_t*)(ws + WS_B), NTOK};
          pg8::gemm_phase<pg8::EpiY>((LAS unsigned char*)lds_raw, g, S, E); }
        { pg8::Gemm g{XB, W1T + (size_t)5120 * DM, NTOK, 2048, DM}; pg8::StaticOrder S; S.init(NTOK, 2048, G, bx); pg8::EpiY E{(bf16_t*)((unsigned char*)p.out + OUT_ZT), 2048};
          pg8::gemm_phase<pg8::EpiY>((LAS unsigned char*)lds_raw, g, S, E); }
    );
    PHASE(4, kf_phase<13>(p, fl, (const _Float16*)(ws + WS_B + (size_t)4096 * NTOK * 2), (uint2*)(ws + WS_A + 64 * MiB)););
    PHASE(5,
        const uint2* KFP = (const uint2*)((unsigned char*)p.out + OUT_KFP); const uint2* KFS = (const uint2*)(ws + WS_A + 64 * MiB);
        { ScRaw vraw[2]; if (bx < 1024) hy_vload<14>(p, bx, 0, threadIdx.x, vraw);
          for (int c = bx; c < 1024; c += G) { hyena_task<14>(p, fl, c, KFP, 0, vraw, c); hyena_task<13>(p, fl, c, KFS, LP, vraw, (c + G < 1024) ? c + G : c); } }
        for (int j = bx; j < 512; j += G) { fnet2_task<14>(p, fl, j, 0, 0); fnet2_task<13>(p, fl, j, LP, 8192); }
    );
    PHASE(6, utrans_phase(p, lds_raw););
    PHASE(7, mix_phase(p, lds_raw););
    PHASE(8, gate_phase(p, lds_raw););
    PHASE(9,
        pg8::Gemm g{(const bf16_t*)(ws + WS_A), (const bf16_t*)(ws + WS_WOT), NTOK, DM, DM}; pg8::StaticOrder S; S.init(NTOK, DM, G, bx);
        pg8::EpiY E{(bf16_t*)(ws + WS_B), DM};
        pg8::gemm_phase<pg8::EpiY>((LAS unsigned char*)lds_raw, g, S, E);
    );
    PHASE(10, final_phase(p););
#undef PHASE
#undef IN
#undef SEAM
}

constexpr int N_PHASES = 11;
#ifndef HOST_TEST
extern "C" void kernel_launch(void* const* d_in, const int* in_sizes, int n_in, void* d_out, int out_size, void* d_ws, size_t ws_size, hipStream_t stream) {
    static int grid = 0;
    if (grid == 0) {
        if (n_in != 21 || out_size != NTOK * DM || ws_size < WS_END) { fprintf(stderr, "kernel_launch: unexpected shapes (n_in %d out %d ws %zu)\n", n_in, out_size, ws_size); grid = -1; return; }
        int dev = 0, cus = 0, per_cu = 0;
        (void)hipGetDevice(&dev); (void)hipDeviceGetAttribute(&cus, hipDeviceAttributeMultiprocessorCount, dev);
        if (hipFuncSetAttribute((const void*)mega, hipFuncAttributeMaxDynamicSharedMemorySize, LDS_BYTES) != hipSuccess) { fprintf(stderr, "kernel_launch: hipFuncSetAttribute failed\n"); grid = -1; return; }
        if (hipOccupancyMaxActiveBlocksPerMultiprocessor(&per_cu, (const void*)mega, NTHR, LDS_BYTES) != hipSuccess || per_cu < 1) { fprintf(stderr, "kernel_launch: occupancy query says %d\n", per_cu); per_cu = 1; }
        (void)hipGetLastError();
        grid = cus;
    }
    if (grid < 0) return;
    Params p{};
    for (int i = 0; i < 21; ++i) p.in[i] = (const float*)d_in[i];
    p.out = (float*)d_out; p.ws = (unsigned char*)d_ws;
#if N_LAUNCH_MODE == 1
    p.ph_lo = 0; p.ph_hi = N_PHASES;
    if (hipMemsetAsync((unsigned char*)d_ws + WS_BAR, 0, XCD_BAR_WORDS * 4, stream) != hipSuccess) { fprintf(stderr, "kernel_launch: memset of the barrier words failed\n"); return; }
    void* args[] = {&p};
    hipError_t e = hipLaunchCooperativeKernel((const void*)mega, dim3(grid), dim3(NTHR), args, LDS_BYTES, stream);
    if (e != hipSuccess) fprintf(stderr, "cooperative launch failed: %s (grid %d)\n", hipGetErrorString(e), grid);
#else
    for (int k = 0; k < N_PHASES; ++k) for (int r = 0; r < (k == PROBE_REP ? 2 : 1); ++r) { p.ph_lo = k; p.ph_hi = k + 1; hipLaunchKernelGGL(mega, dim3(grid), dim3(NTHR), LDS_BYTES, stream, p); }
#endif
}
#endif
```

```cpp
#include <hip/hip_runtime.h>
#include <hip/hip_cooperative_groups.h>
#include <cstdio>
#include <cmath>
namespace cg = cooperative_groups;

#ifndef PROBE_REP
#define PROBE_REP -1
#endif
#ifndef N_LAUNCH_MODE
#define N_LAUNCH_MODE 1
#endif

#define HD __host__ __device__ __forceinline__
#define DV __device__ __forceinline__
#define LAS __attribute__((address_space(3)))
typedef unsigned short bf16_t;
typedef short bf16x8 __attribute__((ext_vector_type(8)));
typedef float f32x4 __attribute__((ext_vector_type(4)));
typedef float f32x16 __attribute__((ext_vector_type(16)));
typedef unsigned u32x4 __attribute__((ext_vector_type(4)));
typedef unsigned u32x2 __attribute__((ext_vector_type(2)));

constexpr int DM = 2048, NTOK = 32768, LP = 16384, LS = 8192, NTHR = 512;
constexpr size_t MiB = 1ull << 20;
constexpr size_t WS_A = 0;
constexpr size_t WS_B = 128 * MiB;
constexpr size_t WS_W1T = 448 * MiB;
constexpr size_t WS_WOT = 476 * MiB;
constexpr size_t WS_RS = 484 * MiB;
constexpr size_t WS_H3 = WS_RS + 128 * 1024;
constexpr size_t WS_W4T = WS_H3 + 3 * MiB;
constexpr size_t WS_TF = WS_W4T + 512 * 1024;
constexpr size_t WS_SSQ = WS_TF + 2 * MiB;
constexpr size_t WS_BAR = WS_SSQ + 4 * MiB;
constexpr size_t WS_WFT = WS_BAR + 16384;
constexpr size_t WS_BMIX = WS_WFT;
constexpr size_t WS_NYQ = WS_SSQ;
constexpr size_t WS_END = WS_WFT + 8 * MiB;
constexpr size_t OUT_KFP = 0, OUT_ZT = 128 * MiB;
constexpr int LDS_BYTES = 139264;

HD unsigned f2bf(float f) { unsigned u = __builtin_bit_cast(unsigned, f); u += 0x7FFFu + ((u >> 16) & 1u); return u >> 16; }
HD float bf2f(unsigned b) { return __builtin_bit_cast(float, b << 16); }
HD unsigned pack_bf2(float lo, float hi) { return f2bf(lo) | (f2bf(hi) << 16); }
HD unsigned pack_h2(float lo, float hi) { _Float16 a = (_Float16)lo, b = (_Float16)hi; return (unsigned)__builtin_bit_cast(unsigned short, a) | ((unsigned)__builtin_bit_cast(unsigned short, b) << 16); }
HD float h_lo(unsigned u) { return (float)__builtin_bit_cast(_Float16, (unsigned short)(u & 0xffffu)); }
HD float h_hi(unsigned u) { return (float)__builtin_bit_cast(_Float16, (unsigned short)(u >> 16)); }
HD void sincos_rev(float rev, float& c, float& s) {
#ifdef __HIP_DEVICE_COMPILE__
    c = __builtin_amdgcn_cosf(rev); s = __builtin_amdgcn_sinf(rev);
#else
    c = cosf(6.283185307179586f * rev); s = sinf(6.283185307179586f * rev);
#endif
}
HD unsigned brev(unsigned x, int nb) { return __builtin_bitreverse32(x) >> (32 - nb); }
#define LPAD(i) ((i) + ((i) >> 5))
HD u32x4 ldnt4(const void* p) { return __builtin_nontemporal_load((const u32x4*)p); }
HD u32x2 ldnt2(const void* p) { return __builtin_nontemporal_load((const u32x2*)p); }
#define SCHED_FENCE()

HD constexpr float c32(int k) {
    return k == 0 ? 1.0f : k == 1 ? 0.98078528040323043f : k == 2 ? 0.92387953251128674f : k == 3 ? 0.83146961230254524f : k == 4 ? 0.70710678118654752f :
           k == 5 ? 0.55557023301960218f : k == 6 ? 0.38268343236508977f : k == 7 ? 0.19509032201612825f : k == 8 ? 0.0f :
           k == 9 ? -0.19509032201612825f : k == 10 ? -0.38268343236508977f : k == 11 ? -0.55557023301960218f : k == 12 ? -0.70710678118654752f :
           k == 13 ? -0.83146961230254524f : k == 14 ? -0.92387953251128674f : -0.98078528040323043f;
}
HD constexpr float s32(int k) {
    return k == 0 ? 0.0f : k == 1 ? 0.19509032201612825f : k == 2 ? 0.38268343236508977f : k == 3 ? 0.55557023301960218f : k == 4 ? 0.70710678118654752f :
           k == 5 ? 0.83146961230254524f : k == 6 ? 0.92387953251128674f : k == 7 ? 0.98078528040323043f : k == 8 ? 1.0f :
           k == 9 ? 0.98078528040323043f : k == 10 ? 0.92387953251128674f : k == 11 ? 0.83146961230254524f : k == 12 ? 0.70710678118654752f :
           k == 13 ? 0.55557023301960218f : k == 14 ? 0.38268343236508977f : 0.19509032201612825f;
}
HD constexpr int brev_c(int x, int nb) { return ((((x & 1) << 4) | ((x & 2) << 2) | (x & 4) | ((x & 8) >> 2) | ((x & 16) >> 4)) >> (5 - nb)); }

typedef float v2f __attribute__((ext_vector_type(2)));
HD v2f cmul(v2f x, v2f w) { return x * w.xx + x.yx * (v2f){-w.y, w.y}; }
template <int RL, bool ZH = false> HD void dif_regs(v2f (&x)[1 << RL]) {
    constexpr int R = 1 << RL;
#pragma unroll
    for (int q = 0; q < RL; ++q) {
        const int half = R >> (q + 1);
#pragma unroll
        for (int j = 0; j < R; ++j) {
            if (j & half) continue;
            const int k32 = ((j & (half - 1)) << q) * (32 / R);
            const v2f a = x[j], b = x[j + half];
            const bool zb = ZH && q == 0;
            x[j] = zb ? a : a + b;
            const v2f d = zb ? a : a - b;
            if (k32 == 0) x[j + half] = d;
            else if (k32 == 8) x[j + half] = (v2f){d.y, -d.x};
            else x[j + half] = cmul(d, (v2f){c32(k32), -s32(k32)});
        }
    }
}
template <int RL, bool LH = false> HD void dit_regs(v2f (&x)[1 << RL]) {
    constexpr int R = 1 << RL;
#pragma unroll
    for (int q = RL - 1; q >= 0; --q) {
        const int half = R >> (q + 1);
#pragma unroll
        for (int j = 0; j < R; ++j) {
            if (j & half) continue;
            const int k32 = ((j & (half - 1)) << q) * (32 / R);
            const v2f a = x[j], b = x[j + half];
            v2f t;
            if (k32 == 0) t = b;
            else if (k32 == 8) t = (v2f){-b.y, b.x};
            else t = cmul(b, (v2f){c32(k32), s32(k32)});
            x[j] = a + t; if (!(LH && q == 0)) x[j + half] = a - t;
        }
    }
}
template <int RL> HD void apply_tw(v2f (&x)[1 << RL], v2f t) {
    constexpr int R = 1 << RL;
    v2f p[4];
    p[0] = (v2f){1.f, 0.f}; p[1] = t; p[2] = cmul(t, t); p[3] = cmul(p[2], t);
    const v2f p4 = cmul(p[2], p[2]);
    v2f bs = p4;
#pragma unroll
    for (int a = 0; a < R / 4; ++a) {
#pragma unroll
        for (int b = 0; b < 4; ++b) {
            const int f = 4 * a + b;
            if (f == 0) continue;
            const v2f w = (a == 0) ? p[b] : (b == 0 ? bs : cmul(bs, p[b]));
            const int e = brev_c(f, RL);
            x[e] = cmul(x[e], w);
        }
        if (a > 0) bs = cmul(bs, p4);
        SCHED_FENCE();
    }
}
template <int SH> HD constexpr int poff(int e) { return (e << SH) + (SH >= 5 ? (e << (SH >= 5 ? SH - 5 : 0)) : (SH == 4 ? (e >> 1) : 0)); }
template <int RL, int SH, bool INV, bool HALF = false> HD void fft_pass(float2* lds, int tid) {
    constexpr int R = 1 << RL, NB = 16384 >> RL;
    static_assert(SH >= 4 || (SH == 0 && RL <= 5), "unsupported pass geometry");
#ifdef __HIP_DEVICE_COMPILE__
    asm volatile("" : "+v"(tid));
#endif
    static_assert(NB % NTHR == 0, "pass geometry");
#pragma unroll
    for (int it = 0; it < NB / NTHR; ++it) {
        const int b = tid + it * NTHR;
        const int lo = b & ((1 << SH) - 1), hi = b >> SH;
        const int base = (hi << (SH + RL)) | lo;
        v2f* pb = (v2f*)lds + LPAD(base);
        v2f x[R];
#pragma unroll
        for (int e = 0; e < R; ++e) x[e] = (HALF && !INV && e >= R / 2) ? (v2f){0.f, 0.f} : pb[poff<SH>(e)];
        float c = 1.f, s = 0.f;
        if (SH > 0) sincos_rev((float)lo * (1.0f / (float)(1 << (SH + RL))), c, s);
        SCHED_FENCE();
        if (!INV) { dif_regs<RL, HALF>(x); SCHED_FENCE(); if (SH > 0) apply_tw<RL>(x, (v2f){c, -s}); }
        else { if (SH > 0) apply_tw<RL>(x, (v2f){c, s}); SCHED_FENCE(); dit_regs<RL, HALF>(x); }
        SCHED_FENCE();
#pragma unroll
        for (int e = 0; e < R; ++e) if (!(HALF && INV && e >= R / 2)) pb[poff<SH>(e)] = x[e];
    }
}

template <int NB> HD int pair_k(int tid, int i) { constexpr int IB = NB - 10; return ((tid & 63) << (3 + IB)) | ((tid >> 6) << IB) | i; }
template <int NB> HD int fz_k(int tp, int item) {
    constexpr int NBB = NB - 4;
    if (tp != 0) return ((int)brev((unsigned)item, 4) << NBB) | (int)brev((unsigned)tp, NBB - 1);
    if (item < 8) return ((int)brev((unsigned)item, 4) << NBB) | (1 << (NBB - 1));
    return (item - 8) << NBB;
}
template <int NB, int NSEQ> HD void kf_pairs(float2* lds, int tid, uint2* kf0, uint2* kf1) {
    constexpr int N = 1 << NB, TPS = NTHR / NSEQ;
#ifdef __HIP_DEVICE_COMPILE__
    asm volatile("" : "+v"(tid));
#endif
    const int q = tid / TPS, tp = tid % TPS, base = q * N;
    uint2* kf = q ? kf1 : kf0;
    for (int item = 0; item < 16; ++item) {
        const int k = fz_k<NB>(tp, item);
        float wc, ws; sincos_rev((float)k * (0.5f / (float)N), wc, ws);
        uint2 o;
        if (k == 0) {
            const float2 z0 = lds[LPAD(base)], zh = lds[LPAD(base + 1)];
            o.x = pack_h2(z0.x + z0.y, z0.x - z0.y); o.y = pack_h2(zh.x, -zh.y);
        } else {
            const float2 zk = lds[LPAD(base + (int)brev(k, NB))], zn = lds[LPAD(base + (int)brev(N - k, NB))];
            const float er = 0.5f * (zk.x + zn.x), ei = 0.5f * (zk.y - zn.y);
            const float orr = 0.5f * (zk.y + zn.y), oi = -0.5f * (zk.x - zn.x);
            const float pr = wc * orr + ws * oi, pi = wc * oi - ws * orr;
            o.x = pack_h2(er + pr, ei + pi); o.y = pack_h2(er - pr, -(ei - pi));
        }
        kf[item * TPS + tp] = o;
    }
}
template <int NB, int NSEQ> HD void kf_prefetch(const uint2* kf, int tid, uint2 (&sl)[16]) {
    constexpr int TPS = NTHR / NSEQ; const int tp = tid % TPS;
#pragma unroll
    for (int i = 0; i < 16; ++i) { const u32x2 v = ldnt2(kf + i * TPS + tp); sl[i].x = v.x; sl[i].y = v.y; }
}
template <int NB> HD void pair_mix(v2f& zk, v2f& zn, float wc, float ws, uint2 sl) {
    constexpr int N = 1 << NB; const float invN = 1.0f / (float)N;
    const float k0 = h_lo(sl.x), k1 = h_hi(sl.x), k2 = h_lo(sl.y), k3 = h_hi(sl.y);
    const float er = 0.5f * (zk.x + zn.x), ei = 0.5f * (zk.y - zn.y);
    const float orr = 0.5f * (zk.y + zn.y), oi = -0.5f * (zk.x - zn.x);
    const float pr = wc * orr + ws * oi, pi = wc * oi - ws * orr;
    const float xkr = er + pr, xki = ei + pi, xnr = er - pr, xni = -(ei - pi);
    const float ykr = xkr * k0 - xki * k1, yki = xkr * k1 + xki * k0;
    const float ynr = xnr * k2 - xni * k3, yni = xnr * k3 + xni * k2;
    const float yer = 0.5f * (ykr + ynr), yei = 0.5f * (yki - yni);
    const float dr = 0.5f * (ykr - ynr), di = 0.5f * (yki + yni);
    const float yor = dr * wc - di * ws, yoi = dr * ws + di * wc;
    zk = (v2f){(yer - yoi) * invN, (yei + yor) * invN};
    zn = (v2f){(yer + yoi) * invN, (-yei + yor) * invN};
}
template <int NB, int NSEQ> HD void conv_mid(float2* lds, int tid, const uint2 (&slots)[16]) {
    constexpr int N = 1 << NB, NBB = NB - 4, TPS = NTHR / NSEQ;
    const float invN = 1.0f / (float)N;
#ifdef __HIP_DEVICE_COMPILE__
    asm volatile("" : "+v"(tid));
#endif
    const int q = tid / TPS, tp = tid % TPS, base = q * N;
    const int bA = 2 * tp, bB = tp ? (int)brev((unsigned)((1 << NBB) - (int)brev((unsigned)bA, NBB)), NBB) : 1;
    v2f* pA = (v2f*)lds + LPAD(base + 16 * bA); v2f* pB = (v2f*)lds + LPAD(base + 16 * bB);
    v2f xa[16], xb[16];
#pragma unroll
    for (int e = 0; e < 16; ++e) { xa[e] = pA[e]; xb[e] = pB[e]; }
    dif_regs<4>(xa); dif_regs<4>(xb);
    float cB, sB; sincos_rev((float)(tp ? (int)brev((unsigned)tp, NBB - 1) : (1 << (NBB - 1))) * (0.5f / (float)N), cB, sB);
#define TWC(E) (c32(E) * cB - s32(E) * sB)
#define TWS(E) (s32(E) * cB + c32(E) * sB)
    if (tp != 0) {
#pragma unroll
        for (int e = 0; e < 16; ++e) pair_mix<NB>(xa[e], xb[15 - e], TWC(brev_c(e, 4)), TWS(brev_c(e, 4)), slots[e]);
    } else {
#pragma unroll
        for (int e = 0; e < 8; ++e) pair_mix<NB>(xb[e], xb[15 - e], TWC(brev_c(e, 4)), TWS(brev_c(e, 4)), slots[e]);
        {
            const float k0 = h_lo(slots[8].x), k1 = h_hi(slots[8].x), k2 = h_lo(slots[8].y), k3 = h_hi(slots[8].y);
            const v2f z0 = xa[0], zh = xa[1];
            const float y0 = (z0.x + z0.y) * k0, yn = (z0.x - z0.y) * k1;
            xa[0] = (v2f){0.5f * (y0 + yn) * invN, 0.5f * (y0 - yn) * invN};
            const float yr = zh.x * k2 + zh.y * k3, yi = zh.x * k3 - zh.y * k2;
            xa[1] = (v2f){yr * invN, -yi * invN};
        }
#pragma unroll
        for (int E = 1; E < 8; ++E) pair_mix<NB>(xa[brev_c(E, 4)], xa[brev_c(16 - E, 4)], c32(E), s32(E), slots[8 + E]);
    }
    dit_regs<4>(xa); dit_regs<4>(xb);
#pragma unroll
    for (int e = 0; e < 16; ++e) { pA[e] = xa[e]; pB[e] = xb[e]; }
}

template <int NB> HD uint2 kf_spec(v2f zk, v2f zn, float wc, float ws) {
    const float er = 0.5f * (zk.x + zn.x), ei = 0.5f * (zk.y - zn.y);
    const float orr = 0.5f * (zk.y + zn.y), oi = -0.5f * (zk.x - zn.x);
    const float pr = wc * orr + ws * oi, pi = wc * oi - ws * orr;
    uint2 o; o.x = pack_h2(er + pr, ei + pi); o.y = pack_h2(er - pr, -(ei - pi)); return o;
}
template <int NB, int NSEQ> HD void kf_mid(float2* lds, int tid, uint2* kf0, uint2* kf1) {
    constexpr int N = 1 << NB, NBB = NB - 4, TPS = NTHR / NSEQ;
#ifdef __HIP_DEVICE_COMPILE__
    asm volatile("" : "+v"(tid));
#endif
    const int q = tid / TPS, tp = tid % TPS, base = q * N;
    uint2* kf = (q ? kf1 : kf0) + tp;
    const int bA = 2 * tp, bB = tp ? (int)brev((unsigned)((1 << NBB) - (int)brev((unsigned)bA, NBB)), NBB) : 1;
    const v2f* pA = (const v2f*)lds + LPAD(base + 16 * bA); const v2f* pB = (const v2f*)lds + LPAD(base + 16 * bB);
    v2f xa[16], xb[16];
#pragma unroll
    for (int e = 0; e < 16; ++e) { xa[e] = pA[e]; xb[e] = pB[e]; }
    dif_regs<4>(xa); dif_regs<4>(xb);
    float cB, sB; sincos_rev((float)(tp ? (int)brev((unsigned)tp, NBB - 1) : (1 << (NBB - 1))) * (0.5f / (float)N), cB, sB);
    if (tp != 0) {
#pragma unroll
        for (int e = 0; e < 16; ++e) kf[e * TPS] = kf_spec<NB>(xa[e], xb[15 - e], TWC(brev_c(e, 4)), TWS(brev_c(e, 4)));
    } else {
#pragma unroll
        for (int e = 0; e < 8; ++e) kf[e * TPS] = kf_spec<NB>(xb[e], xb[15 - e], TWC(brev_c(e, 4)), TWS(brev_c(e, 4)));
        { const v2f z0 = xa[0], zh = xa[1]; uint2 o; o.x = pack_h2(z0.x + z0.y, z0.x - z0.y); o.y = pack_h2(zh.x, -zh.y); kf[8 * TPS] = o; }
#pragma unroll
        for (int E = 1; E < 8; ++E) kf[(8 + E) * TPS] = kf_spec<NB>(xa[brev_c(E, 4)], xa[brev_c(16 - E, 4)], c32(E), s32(E));
    }
}

namespace pg8 {
constexpr int BM = 256, BK = 64, HALF = 128, HTB = HALF * BK * 2, STAGE_BYTES = 8 * HTB, NXCD = 8, WGM = 8;
__host__ __device__ __forceinline__ int lds_byte(int r, int c) { const int st = (r >> 4) * 2 + (c >> 5), rr = r & 15, cc = c & 31, ob = rr * 64 + cc * 2; return st * 1024 + (ob ^ (((ob >> 9) & 1) << 5)); }
__host__ __device__ __forceinline__ void stage_rc(int b, int& R, int& C) { const int st = b / 1024, sb = b % 1024, swz = sb ^ (((sb >> 9) & 1) << 5); R = (st >> 1) * 16 + swz / 64; C = (st & 1) * 32 + (swz % 64) / 2; }
__host__ __device__ __forceinline__ int perm32(int rho) { const int n = rho >> 4, i = rho & 15; return 8 * (i >> 2) + 4 * n + (i & 3); }
struct Unit { int pm, pn; };
struct Gemm { const bf16_t* A; const bf16_t* Bt; int M, N, K; };
struct StaticOrder {
    int nM, nN, nwg, G, c;
    __host__ __device__ void init(int M, int N, int G_, int c_) { nM = M / BM; nN = N / BM; nwg = nM * nN; G = G_; c = c_; }
    __host__ __device__ bool next(int i, Unit& u) const {
        const long L = (long)i * G + c; if (L >= nwg) return false;
        int wgid = (int)L; { const int q = nwg / NXCD, r = nwg % NXCD, xcd = wgid % NXCD, off = wgid / NXCD; wgid = (xcd < r ? xcd * (q + 1) : r * (q + 1) + (xcd - r) * q) + off; }
        const int nig = WGM * nN, gid = wgid / nig, fm = gid * WGM, gsz = (nM - fm) < WGM ? (nM - fm) : WGM;
        u.pm = fm + ((wgid % nig) % gsz); u.pn = (wgid % nig) / gsz; return true;
    }
};
__device__ __forceinline__ unsigned cvt_pk_bf16(float lo, float hi) { unsigned r; asm volatile("v_cvt_pk_bf16_f32 %0, %1, %2" : "=v"(r) : "v"(lo), "v"(hi)); return r; }

template <class Epi>
__device__ __forceinline__ void gemm_phase(LAS unsigned char* lds, const Gemm g, const StaticOrder& S, const Epi& E) {
    const int tid = threadIdx.x, wid = __builtin_amdgcn_readfirstlane(tid >> 6), lane = tid & 63, wr = wid >> 2, wc = wid & 3, fr = lane & 15, fq = lane >> 4;
    const int K = g.K, nt = K / BK;
    unsigned voffA[2], voffB[2];
#pragma unroll
    for (int i = 0; i < 2; ++i) { int R, C; stage_rc(tid * 16 + i * 8192, R, C); const int Rb = Epi::PERM ? ((R & ~31) + perm32(R & 31)) : R;
        voffA[i] = (unsigned)(R * K + C) * 2u; voffB[i] = (unsigned)(Rb * K + C) * 2u; }
    const size_t kstep = (size_t)(BK * 2);
    const size_t hstep = (size_t)HALF * K * 2;
    const size_t tstep = 2 * hstep;
    const unsigned ldsw = (unsigned)wid * 1024u;
    const int aoff = lds_byte(wr * 64 + fr, fq * 8), boff = lds_byte(wc * 32 + fr, fq * 8);
#define PG8_SA(b, h) (((b) * 2 + (h)) * HTB)
#define PG8_SB(b, h) ((4 + (b) * 2 + (h)) * HTB)
#define PG8_STAGE(bufoff, gbase, voff) do { _Pragma("unroll") for (int _i = 0; _i < 2; ++_i) \
        __builtin_amdgcn_global_load_lds((const unsigned*)((const char*)(gbase) + (voff)[_i]), (LAS unsigned*)(lds + (bufoff) + ldsw + _i * 8192), 16, 0, 0); } while (0)
#define PG8_LDA(dst, b, h) do { _Pragma("unroll") for (int m = 0; m < 4; ++m) _Pragma("unroll") for (int k = 0; k < 2; ++k) dst[m][k] = *(const LAS bf16x8*)(lds + PG8_SA(b, h) + aoff + m * 2048 + k * 1024); } while (0)
#define PG8_LDB(dst, b, h) do { _Pragma("unroll") for (int n = 0; n < 2; ++n) _Pragma("unroll") for (int k = 0; k < 2; ++k) dst[n][k] = *(const LAS bf16x8*)(lds + PG8_SB(b, h) + boff + n * 2048 + k * 1024); } while (0)
#define PG8_MMA(ai, bj, At, Bt) do { __builtin_amdgcn_s_setprio(1); _Pragma("unroll") for (int m = 0; m < 4; ++m) _Pragma("unroll") for (int n = 0; n < 2; ++n) _Pragma("unroll") for (int k = 0; k < 2; ++k) \
        acc[ai][bj][m][n] = __builtin_amdgcn_mfma_f32_16x16x32_bf16(Bt[n][k], At[m][k], acc[ai][bj][m][n], 0, 0, 0); __builtin_amdgcn_s_setprio(0); } while (0)
#define PG8_WAIT_V(n) asm volatile("s_waitcnt vmcnt(" #n ")" ::: "memory")
#define PG8_WAIT_L(n) asm volatile("s_waitcnt lgkmcnt(" #n ")" ::: "memory")
#define PG8_BAR __builtin_amdgcn_s_barrier()
#define PG8_SCHED __builtin_amdgcn_sched_barrier(0)
    Unit cur, nxt; int ui = 0;
    if (!S.next(0, cur)) return;
    f32x4 acc[2][2][4][2];
#pragma unroll
    for (int a = 0; a < 2; ++a)
#pragma unroll
        for (int b = 0; b < 2; ++b)
#pragma unroll
            for (int m = 0; m < 4; ++m)
#pragma unroll
                for (int n = 0; n < 2; ++n) acc[a][b][m][n] = (f32x4){0.f, 0.f, 0.f, 0.f};
    bf16x8 At[4][2], B0[2][2], B1[2][2];
    const char* cA = (const char*)g.A + (size_t)cur.pm * tstep; const char* cB = (const char*)g.Bt + (size_t)cur.pn * tstep;
    PG8_STAGE(PG8_SB(0, 0), cB, voffB); PG8_STAGE(PG8_SA(0, 0), cA, voffA); PG8_STAGE(PG8_SB(0, 1), cB + hstep, voffB); PG8_STAGE(PG8_SA(0, 1), cA + hstep, voffA);
    if (wr == 1) PG8_BAR;
    PG8_WAIT_V(4); PG8_BAR;
    PG8_STAGE(PG8_SB(1, 0), cB + kstep, voffB); PG8_STAGE(PG8_SA(1, 0), cA + kstep, voffA); PG8_STAGE(PG8_SB(1, 1), cB + hstep + kstep, voffB);
    PG8_WAIT_V(6); PG8_BAR;
    for (;;) {
        const bool has_next = S.next(ui + 1, nxt);
        const char* nA = has_next ? (const char*)g.A + (size_t)nxt.pm * tstep : cA; const char* nB = has_next ? (const char*)g.Bt + (size_t)nxt.pn * tstep : cB;
        for (int t = 0; t < nt; t += 2) {
            const bool last = (t == nt - 2);
            const char* a1 = cA + (size_t)(t + 1) * kstep;
            const char* a2 = last ? nA : cA + (size_t)(t + 2) * kstep; const char* b2 = last ? nB : cB + (size_t)(t + 2) * kstep;
            const char* a3 = a2 + kstep; const char* b3 = b2 + kstep;
            PG8_LDB(B0, 0, 0); PG8_SCHED; PG8_LDA(At, 0, 0); PG8_STAGE(PG8_SA(1, 1), a1 + hstep, voffA);
            PG8_WAIT_L(8); PG8_BAR; PG8_WAIT_L(0); PG8_MMA(0, 0, At, B0); PG8_BAR; PG8_SCHED;
            PG8_LDB(B1, 0, 1); PG8_STAGE(PG8_SB(0, 0), b2, voffB);
            PG8_BAR; PG8_WAIT_L(0); PG8_MMA(0, 1, At, B1); PG8_BAR;
            PG8_LDA(At, 0, 1); PG8_STAGE(PG8_SA(0, 0), a2, voffA);
            PG8_BAR; PG8_WAIT_L(0); PG8_MMA(1, 0, At, B0); PG8_BAR; PG8_SCHED;
            PG8_STAGE(PG8_SB(0, 1), b2 + hstep, voffB);
            PG8_WAIT_V(6); PG8_BAR; PG8_MMA(1, 1, At, B1); PG8_BAR;
            PG8_LDB(B0, 1, 0); PG8_SCHED; PG8_LDA(At, 1, 0); PG8_STAGE(PG8_SA(0, 1), a2 + hstep, voffA);
            PG8_WAIT_L(8); PG8_BAR; PG8_WAIT_L(0); PG8_MMA(0, 0, At, B0); PG8_BAR; PG8_SCHED;
            PG8_LDB(B1, 1, 1); PG8_STAGE(PG8_SB(1, 0), b3, voffB);
            PG8_BAR; PG8_WAIT_L(0); PG8_MMA(0, 1, At, B1); PG8_BAR;
            PG8_LDA(At, 1, 1); PG8_STAGE(PG8_SA(1, 0), a3, voffA);
            PG8_BAR; PG8_WAIT_L(0); PG8_MMA(1, 0, At, B0); PG8_BAR; PG8_SCHED;
            PG8_STAGE(PG8_SB(1, 1), b3 + hstep, voffB);
            PG8_WAIT_V(6); PG8_BAR; PG8_MMA(1, 1, At, B1); PG8_BAR;
        }
        E(acc, cur, wr, wc, fr, fq);
        if (!has_next) break;
#pragma unroll
        for (int a = 0; a < 2; ++a)
#pragma unroll
            for (int b = 0; b < 2; ++b)
#pragma unroll
                for (int m = 0; m < 4; ++m)
#pragma unroll
                    for (int n = 0; n < 2; ++n) acc[a][b][m][n] = (f32x4){0.f, 0.f, 0.f, 0.f};
        cur = nxt; cA = nA; cB = nB; ++ui;
    }
    PG8_WAIT_V(0);
    if (wr == 0) PG8_BAR;
    PG8_BAR;
#undef PG8_SA
#undef PG8_SB
#undef PG8_STAGE
#undef PG8_LDA
#undef PG8_LDB
#undef PG8_MMA
#undef PG8_WAIT_V
#undef PG8_WAIT_L
#undef PG8_BAR
#undef PG8_SCHED
}

struct EpiPT {
    static constexpr bool PERM = true;
    bf16_t* O; int ldc; const float* cs;
    __device__ __forceinline__ void operator()(const f32x4 (&acc)[2][2][4][2], const Unit& u, int wr, int wc, int fr, int fq) const {
        const int row0 = u.pm * BM + wr * 64 + fr, col0 = u.pn * BM + wc * 32 + 8 * fq;
        f32x4 sv[2][2];
#pragma unroll
        for (int bj = 0; bj < 2; ++bj)
#pragma unroll
            for (int n = 0; n < 2; ++n) sv[bj][n] = *(const f32x4*)(cs + col0 + bj * HALF + 4 * n);
#pragma unroll
        for (int ai = 0; ai < 2; ++ai)
#pragma unroll
            for (int m = 0; m < 4; ++m) { bf16_t* rowp = O + (size_t)(row0 + ai * HALF + m * 16) * ldc + col0;
#pragma unroll
                for (int bj = 0; bj < 2; ++bj) { const f32x4 v0 = acc[ai][bj][m][0] * sv[bj][0], v1 = acc[ai][bj][m][1] * sv[bj][1];
                    u32x4 w; w.x = cvt_pk_bf16(v0[0], v0[1]); w.y = cvt_pk_bf16(v0[2], v0[3]); w.z = cvt_pk_bf16(v1[0], v1[1]); w.w = cvt_pk_bf16(v1[2], v1[3]);
                    *(u32x4*)(rowp + bj * HALF) = w; } }
    }
};
__device__ __forceinline__ float silu_f(float z) { return z * __builtin_amdgcn_rcpf(1.0f + __expf(-z)); }
struct EpiZT {
    static constexpr bool PERM = true;
    bf16_t* O; int ldc; const float* rs;
    __device__ __forceinline__ void operator()(const f32x4 (&acc)[2][2][4][2], const Unit& u, int wr, int wc, int fr, int fq) const {
        const int row0 = u.pm * BM + wr * 64 + fr, col0 = u.pn * BM + wc * 32 + 8 * fq;
#pragma unroll
        for (int ai = 0; ai < 2; ++ai)
#pragma unroll
            for (int m = 0; m < 4; ++m) { const int row = row0 + ai * HALF + m * 16; const float s = rs[row]; bf16_t* rowp = O + (size_t)row * ldc + col0;
#pragma unroll
                for (int bj = 0; bj < 2; ++bj) { const f32x4 v0 = acc[ai][bj][m][0] * s, v1 = acc[ai][bj][m][1] * s;
                    u32x4 w; w.x = cvt_pk_bf16(v0[0], v0[1]); w.y = cvt_pk_bf16(v0[2], v0[3]); w.z = cvt_pk_bf16(v1[0], v1[1]); w.w = cvt_pk_bf16(v1[2], v1[3]);
                    *(u32x4*)(rowp + bj * HALF) = w; } }
    }
};
struct EpiY {
    static constexpr bool PERM = true;
    bf16_t* O; int ldc;
    __device__ __forceinline__ void operator()(const f32x4 (&acc)[2][2][4][2], const Unit& u, int wr, int wc, int fr, int fq) const {
        const int row0 = u.pm * BM + wr * 64 + fr, col0 = u.pn * BM + wc * 32 + 8 * fq;
#pragma unroll
        for (int ai = 0; ai < 2; ++ai)
#pragma unroll
            for (int m = 0; m < 4; ++m) { bf16_t* rowp = O + (size_t)(row0 + ai * HALF + m * 16) * ldc + col0;
#pragma unroll
                for (int bj = 0; bj < 2; ++bj) { const f32x4 v0 = acc[ai][bj][m][0], v1 = acc[ai][bj][m][1];
                    u32x4 w; w.x = cvt_pk_bf16(v0[0], v0[1]); w.y = cvt_pk_bf16(v0[2], v0[3]); w.z = cvt_pk_bf16(v1[0], v1[1]); w.w = cvt_pk_bf16(v1[2], v1[3]);
                    *(u32x4*)(rowp + bj * HALF) = w; } }
    }
};
struct EpiMix {
    static constexpr bool PERM = true;
    bf16_t* YG; const float* bias; int g, mirror;
    __device__ __forceinline__ void operator()(const f32x4 (&acc)[2][2][4][2], const Unit& u, int wr, int wc, int fr, int fq) const {
        const int r0 = u.pm * BM;
        const int L = r0 < 8192 ? LP : LS, kb = r0 < 8192 ? 0 : (r0 < 12288 ? 8192 : 12288), tok0 = r0 < 8192 ? 0 : (r0 < 12288 ? LP : LP + LS);
        const float scale = r0 < 8192 ? (1.0f / 2048.0f) : 0.00069053396600248786f;
        const int col0 = g * 256 + wc * 32 + 8 * fq;
        f32x4 bv[2][2];
#pragma unroll
        for (int bj = 0; bj < 2; ++bj)
#pragma unroll
            for (int n = 0; n < 2; ++n) bv[bj][n] = *(const f32x4*)(bias + col0 + bj * HALF + 4 * n);
#pragma unroll
        for (int ai = 0; ai < 2; ++ai)
#pragma unroll
            for (int m = 0; m < 4; ++m) { const int k = r0 - kb + wr * 64 + fr + ai * HALF + m * 16;
                if (mirror && k == 0) continue;
                bf16_t* rowp = YG + (size_t)(tok0 + (mirror ? L - k : k)) * 1024 + col0;
#pragma unroll
                for (int bj = 0; bj < 2; ++bj) { const f32x4 v0 = acc[ai][bj][m][0] * scale + bv[bj][0], v1 = acc[ai][bj][m][1] * scale + bv[bj][1];
                    u32x4 w; w.x = cvt_pk_bf16(v0[0], v0[1]); w.y = cvt_pk_bf16(v0[2], v0[3]); w.z = cvt_pk_bf16(v1[0], v1[1]); w.w = cvt_pk_bf16(v1[2], v1[3]);
                    *(u32x4*)(rowp + bj * HALF) = w; } }
    }
};
struct EpiOut {
    static constexpr bool PERM = false;
    float* C; const float* xp; const float* xs; float* ssq;
    __device__ __forceinline__ void operator()(const f32x4 (&acc)[2][2][4][2], const Unit& u, int wr, int wc, int fr, int fq) const {
        const int row0 = u.pm * BM + wr * 64 + fr, col0 = u.pn * BM + wc * 32 + 4 * fq;
#pragma unroll
        for (int ai = 0; ai < 2; ++ai)
#pragma unroll
            for (int m = 0; m < 4; ++m) { const int row = row0 + ai * HALF + m * 16;
                const float* xr = (row < LP ? xp + (size_t)row * DM : xs + (size_t)(row - LP) * DM) + col0; float* cr = C + (size_t)row * DM + col0; float q = 0.f;
#pragma unroll
                for (int bj = 0; bj < 2; ++bj)
#pragma unroll
                    for (int n = 0; n < 2; ++n) { const f32x4 o = acc[ai][bj][m][n] + *(const f32x4*)(xr + bj * HALF + n * 16); *(f32x4*)(cr + bj * HALF + n * 16) = o;
                        q += (o[0] * o[0] + o[1] * o[1]) + (o[2] * o[2] + o[3] * o[3]); }
                q += __shfl_xor(q, 16); q += __shfl_xor(q, 32);
                if (fq == 0) ssq[(size_t)row * 32 + u.pn * 4 + wc] = q; }
    }
};
}


#define XB_TMO      128
#define XB_XCNT(j)  (256  + 64 * (j))
#define XB_XSUB(j)  (1280 + 64 * (j))
#define XB_XGEN(j)  (2304 + 64 * (j))
#define XB_TOP      3328
#define XB_TOPGEN   3392
#define XCD_BAR_WORDS 3456
#define XB_SPIN_CAP (1u << 20)
DV unsigned xb_ld(unsigned* p)              { return __hip_atomic_load(p, __ATOMIC_RELAXED, __HIP_MEMORY_SCOPE_AGENT); }
DV unsigned xb_add(unsigned* p, unsigned v) { return __hip_atomic_fetch_add(p, v, __ATOMIC_RELAXED, __HIP_MEMORY_SCOPE_AGENT); }
DV unsigned xb_xcc_id() { return (unsigned)__builtin_amdgcn_s_getreg((3 << 11) | 20) & 0xFu; }
#define XB_SPIN(cond, bar) do { unsigned _sp = 0; while (cond) { __builtin_amdgcn_s_sleep(1); \
    if ((++_sp & 255u) == 0u) { if (xb_ld(&(bar)[XB_TMO])) break; if (_sp > XB_SPIN_CAP) { atomicAdd(&(bar)[XB_TMO], 1u); break; } } } } while (0)
struct XcdBarrier { unsigned* bar; unsigned x; volatile LAS unsigned* st; };
DV XcdBarrier xcd_barrier_post(unsigned* bar, volatile LAS unsigned* st) {
    XcdBarrier b; b.bar = bar; b.x = xb_xcc_id(); b.st = st;
    if (threadIdx.x == 0) (void)xb_add(&bar[XB_XCNT(b.x)], 1u);
    return b;
}
DV void xcd_barrier_complete(unsigned* bar, unsigned x, unsigned& nloc, unsigned& nx) {
    const unsigned G = gridDim.x * gridDim.y * gridDim.z;
    unsigned sum, cnt, mine, sp = 0u;
    for (;;) {
        sum = 0u; cnt = 0u; mine = 0u;
#pragma unroll
        for (unsigned j = 0; j < 16; ++j) { const unsigned c = xb_ld(&bar[XB_XCNT(j)]); sum += c; cnt += (c > 0u) ? 1u : 0u; mine = (j == x) ? c : mine; }
        if (sum == G) break;
        __builtin_amdgcn_s_sleep(1);
        if ((++sp & 255u) == 0u) { if (xb_ld(&bar[XB_TMO])) break; if (sp > XB_SPIN_CAP) { atomicAdd(&bar[XB_TMO], 1u); break; } }
    }
    nloc = mine > 0u ? mine : 1u; nx = cnt > 0u ? cnt : 1u;
}
DV void xcd_barrier(const XcdBarrier& b) {
    asm volatile("s_waitcnt vmcnt(0)" ::: "memory");
    __syncthreads();
    if (threadIdx.x == 0) {
        unsigned* bar = b.bar;
        __builtin_amdgcn_s_waitcnt(0);
        unsigned nloc = b.st[0], nx = b.st[1];
        if (nloc == 0u) { xcd_barrier_complete(bar, b.x, nloc, nx); b.st[0] = nloc; b.st[1] = nx; }
        const unsigned old = xb_add(&bar[XB_XSUB(b.x)], 1u);
        const unsigned gen = old / nloc;
        if (old + 1u == (gen + 1u) * nloc) {
            __builtin_amdgcn_fence(__ATOMIC_RELEASE, "agent");
            asm volatile("s_waitcnt vmcnt(0)" ::: "memory");
            const unsigned og = xb_add(&bar[XB_TOP], 1u);
            const unsigned tg = og / nx;
            if (og + 1u == (tg + 1u) * nx) xb_add(&bar[XB_TOPGEN], 1u);
            else XB_SPIN(xb_ld(&bar[XB_TOPGEN]) == tg, bar);
            __builtin_amdgcn_fence(__ATOMIC_ACQUIRE, "agent");
            xb_add(&bar[XB_XGEN(b.x)], 1u);
            asm volatile("s_waitcnt vmcnt(0)" ::: "memory");
        } else {
            XB_SPIN(xb_ld(&bar[XB_XGEN(b.x)]) == gen, bar);
            __builtin_amdgcn_fence(__ATOMIC_ACQUIRE, "agent");
            asm volatile("s_waitcnt vmcnt(0)" ::: "memory");
        }
    }
    __syncthreads();
}

struct Params { const float* in[21]; float* out; unsigned char* ws; int ph_lo, ph_hi; };
enum { I_XP = 0, I_XS, I_NORMG, I_WIN, I_CONVW, I_CONVB, I_FW1, I_FB1, I_FW2, I_FB2, I_FW3, I_FB3, I_FW4, I_FREQ, I_SKIP, I_FNW, I_FNB, I_NHY, I_NFN, I_WOUT, I_FNORM };

DV float wave_sum(float v) {
#pragma unroll
    for (int o = 32; o > 0; o >>= 1) v += __shfl_xor(v, o);
    return v;
}

DV void transpose_tile(float* tl, const float* src, int ld, int k0, int c0, const float* sc, bf16_t* dst, int row0, int ldd, int lane) {
#pragma unroll
    for (int it = 0; it < 16; ++it) {
        const int k = it * 4 + (lane >> 4), cc = (lane & 15) * 4; const f32x4 a = *(const f32x4*)(src + (size_t)(k0 + k) * ld + c0 + cc);
        const float f = sc ? sc[k0 + k] : 1.0f; float* t = tl + k * 65 + cc; t[0] = a[0] * f; t[1] = a[1] * f; t[2] = a[2] * f; t[3] = a[3] * f;
    }
    asm volatile("s_waitcnt lgkmcnt(0)" ::: "memory"); __builtin_amdgcn_wave_barrier();
#pragma unroll
    for (int kc = 0; kc < 8; ++kc) {
        const int kk = kc * 8; u32x4 w;
        w.x = pack_bf2(tl[(kk + 0) * 65 + lane], tl[(kk + 1) * 65 + lane]); w.y = pack_bf2(tl[(kk + 2) * 65 + lane], tl[(kk + 3) * 65 + lane]);
        w.z = pack_bf2(tl[(kk + 4) * 65 + lane], tl[(kk + 5) * 65 + lane]); w.w = pack_bf2(tl[(kk + 6) * 65 + lane], tl[(kk + 7) * 65 + lane]);
        *(u32x4*)(dst + (size_t)(row0 + lane) * ldd + k0 + kk) = w;
    }
    asm volatile("s_waitcnt lgkmcnt(0)" ::: "memory"); __builtin_amdgcn_wave_barrier();
}

DV void transpose_tile_f32(float* tl, const float* src, int ld, int k0, int c0, const float* sc, float* dst, int row0, int ldd, int lane) {
#pragma unroll
    for (int it = 0; it < 16; ++it) {
        const int k = it * 4 + (lane >> 4), cc = (lane & 15) * 4; const f32x4 a = *(const f32x4*)(src + (size_t)(k0 + k) * ld + c0 + cc);
        const float f = sc ? sc[k0 + k] : 1.0f; float* t = tl + k * 65 + cc; t[0] = a[0] * f; t[1] = a[1] * f; t[2] = a[2] * f; t[3] = a[3] * f;
    }
    asm volatile("s_waitcnt lgkmcnt(0)" ::: "memory"); __builtin_amdgcn_wave_barrier();
#pragma unroll
    for (int kc = 0; kc < 16; ++kc) {
        const int kk = kc * 4; f32x4 w; w[0] = tl[(kk + 0) * 65 + lane]; w[1] = tl[(kk + 1) * 65 + lane]; w[2] = tl[(kk + 2) * 65 + lane]; w[3] = tl[(kk + 3) * 65 + lane];
        *(f32x4*)(dst + (size_t)(row0 + lane) * ldd + k0 + kk) = w;
    }
    asm volatile("s_waitcnt lgkmcnt(0)" ::: "memory"); __builtin_amdgcn_wave_barrier();
}

DV void phase0(const Params& p, unsigned char* lds_raw) {
    const int tid = threadIdx.x, lane = tid & 63, wid = tid >> 6, G0 = gridDim.x, bx0 = blockIdx.x;
    unsigned char* ws = p.ws;
    const int NTF = G0 > 32 ? 16 : 0;
    const bool tf_role = NTF == 0 || bx0 < NTF, common_role = NTF == 0 || bx0 >= NTF;
    const int G = common_role ? G0 - NTF : G0, bx = common_role ? bx0 - NTF : bx0;
    if (common_role) {
        bf16_t* XB = (bf16_t*)(ws + WS_A);
        for (int row0 = bx * 8 + wid; row0 < NTOK; row0 += 2 * G * 8) {
            const int rows[2] = {row0, row0 + G * 8};
            f32x4 va[2][4], vb[2][4];
#pragma unroll
            for (int u = 0; u < 2; ++u) { const int row = rows[u] < NTOK ? rows[u] : row0;
                const float* xr = row < LP ? p.in[I_XP] + (size_t)row * DM : p.in[I_XS] + (size_t)(row - LP) * DM;
#pragma unroll
                for (int j = 0; j < 4; ++j) { const int c = j * 512 + lane * 8; va[u][j] = __builtin_nontemporal_load((const f32x4*)(xr + c)); vb[u][j] = __builtin_nontemporal_load((const f32x4*)(xr + c + 4)); } }
#pragma unroll
            for (int u = 0; u < 2; ++u) { const int row = rows[u]; if (row >= NTOK) continue;
                float q = 0.f;
#pragma unroll
                for (int j = 0; j < 4; ++j) { const f32x4 a = va[u][j], b = vb[u][j];
                    q += (a[0] * a[0] + a[1] * a[1]) + (a[2] * a[2] + a[3] * a[3]) + (b[0] * b[0] + b[1] * b[1]) + (b[2] * b[2] + b[3] * b[3]); }
                q = wave_sum(q);
                const float rs = rsqrtf(q * (1.0f / DM) + 1e-6f);
#pragma unroll
                for (int j = 0; j < 4; ++j) { const int c = j * 512 + lane * 8; const f32x4 a = va[u][j] * rs, b = vb[u][j] * rs;
                    u32x4 w; w.x = pack_bf2(a[0], a[1]); w.y = pack_bf2(a[2], a[3]); w.z = pack_bf2(b[0], b[1]); w.w = pack_bf2(b[2], b[3]);
                    *(u32x4*)(XB + (size_t)row * DM + c) = w; } }
        }
    }
    if (common_role) {
        float* W1 = (float*)lds_raw; float* W2 = W1 + 33 * 64; float* W3 = W2 + 64 * 64; float* B1 = W3 + 64 * 64; float* B2 = B1 + 64; float* B3 = B2 + 64; float* FR = B3 + 64;
        for (int i = tid; i < 33 * 64; i += NTHR) W1[i] = p.in[I_FW1][i];
        for (int i = tid; i < 64 * 64; i += NTHR) { W2[i] = p.in[I_FW2][i]; W3[i] = p.in[I_FW3][i]; }
        if (tid < 64) { B1[tid] = p.in[I_FB1][tid]; B2[tid] = p.in[I_FB2][tid]; B3[tid] = p.in[I_FB3][tid]; FR[tid] = p.in[I_FREQ][tid]; }
        __syncthreads();
        bf16_t* H3 = (bf16_t*)(ws + WS_H3);
        const float fr = FR[lane] * 0.15915494309189535f;
        for (int pos = bx * 8 + wid; pos < LP + LS; pos += G * 8) {
            const int L = pos < LP ? LP : LS, n = pos < LP ? pos : pos - LP;
            float z;
            if (lane == 0) z = (float)n / (float)(L - 1);
            else {
                const int j = (lane - 1) & 15; const float f = 1e-4f + (float)j * ((15.0f - 1e-4f) / 15.0f);
                const float rev = (float)n * f / (float)L;
                z = (lane <= 16) ? __builtin_amdgcn_cosf(rev) : -__builtin_amdgcn_sinf(rev);
            }
            float a = B1[lane];
#pragma unroll
            for (int i = 0; i < 33; ++i) a += __builtin_bit_cast(float, __builtin_amdgcn_readlane(__builtin_bit_cast(int, z), i)) * W1[i * 64 + lane];
            float h = __builtin_amdgcn_sinf(fr * a);
            a = B2[lane];
#pragma unroll
            for (int i = 0; i < 64; ++i) a += __builtin_bit_cast(float, __builtin_amdgcn_readlane(__builtin_bit_cast(int, h), i)) * W2[i * 64 + lane];
            h = __builtin_amdgcn_sinf(fr * a);
            a = B3[lane];
#pragma unroll
            for (int i = 0; i < 64; ++i) a += __builtin_bit_cast(float, __builtin_amdgcn_readlane(__builtin_bit_cast(int, h), i)) * W3[i * 64 + lane];
            h = __builtin_amdgcn_sinf(fr * a);
            H3[(size_t)pos * 64 + lane] = (bf16_t)f2bf(h);
        }
        __syncthreads();
    }
    if (common_role) {
        float* tl = (float*)lds_raw + wid * (64 * 65);
        bf16_t* W1T = (bf16_t*)(ws + WS_W1T); bf16_t* WOT = (bf16_t*)(ws + WS_WOT); bf16_t* W4T = (bf16_t*)(ws + WS_W4T);
        for (int t = bx * 8 + wid; t < 32 * 96 + 32 * 32 + 64; t += G * 8) {
            if (t < 32 * 96) {
                const int kt = t & 31, ct = t >> 5; const int pc = ct * 64;
                const int row = pc < 3072 ? pc : (pc < 4096 ? 5120 + (pc - 3072) : (pc < 5120 ? 3072 + (pc - 4096) : 6144 + (pc - 5120)));
                transpose_tile(tl, p.in[I_WIN], 6144, kt * 64, pc, p.in[I_NORMG], W1T, row, DM, lane);
            } else if (t < 32 * 96 + 32 * 32) {
                const int u = t - 32 * 96, kt = u & 31, ct = u >> 5; const float* sc = kt < 16 ? p.in[I_NHY] : p.in[I_NFN] - 1024;
                transpose_tile(tl, p.in[I_WOUT], DM, kt * 64, ct * 64, sc, WOT, ct * 64, DM, lane);
            } else { const int u = t - 32 * 96 - 32 * 32; transpose_tile(tl, p.in[I_FW4], 4096, 0, u * 64, nullptr, W4T, u * 64, 64, lane); }
        }
        __syncthreads();
    }
    {
        float2* fl = (float2*)lds_raw; float* TF = (float*)(ws + WS_TF);
        for (int t = bx0; tf_role && t < 16; t += (NTF ? NTF : G0)) {
            const int g = t >> 2, d0 = (t & 3) * 64;
            for (int e = tid; e < 16384; e += NTHR) { const int i = e & 63, f = e >> 6; fl[LPAD(i * 256 + f)] = make_float2(p.in[I_FNW][((size_t)g * 256 + f) * 256 + d0 + i], 0.f); }
            __syncthreads();
            fft_pass<4, 4, false>(fl, tid); __syncthreads();
            fft_pass<4, 0, false>(fl, tid); __syncthreads();
            for (int e = tid; e < 16384; e += NTHR) { const int i = e & 63, c = e >> 6; const float2 v = fl[LPAD(i * 256 + (int)brev(c, 8))];
                TF[(((size_t)g * 2 + 0) * 256 + c) * 256 + d0 + i] = v.x; TF[(((size_t)g * 2 + 1) * 256 + c) * 256 + d0 + i] = v.y; }
            { bf16_t* B1 = (bf16_t*)(ws + WS_BMIX); bf16_t* B2 = B1 + 4 * 256 * 512;
              for (int e = tid; e < 16384; e += NTHR) { const int c = e & 255, i = e >> 8; const float2 v = fl[LPAD(i * 256 + (int)brev(c, 8))];
                  const size_t o = ((size_t)g * 256 + d0 + i) * 512 + c;
                  B1[o] = (bf16_t)f2bf(v.x); B1[o + 256] = (bf16_t)f2bf(-v.y); B2[o] = (bf16_t)f2bf(v.x); B2[o + 256] = (bf16_t)f2bf(v.y); } }
            __syncthreads();
        }
    }
}

DV void h_gemm(const Params& p, unsigned char* lds_raw, _Float16* H, int pos0, int L) {
    const int tid = threadIdx.x, lane = tid & 63, wid = tid >> 6, G = gridDim.x;
    const bf16_t* H3 = (const bf16_t*)(p.ws + WS_H3) + (size_t)pos0 * 64; const bf16_t* W4T = (const bf16_t*)(p.ws + WS_W4T);
    unsigned char* wl = lds_raw + wid * 4608;
    const int ntg = L / 512, ntask = 128 * ntg;
    const int r = lane & 31, hh = lane >> 5;
    for (int task = blockIdx.x * 8 + wid; task < ntask; task += G * 8) {
        const int ct = task / ntg, tg = task % ntg;
        bf16x8 bf[4];
#pragma unroll
        for (int s = 0; s < 4; ++s) bf[s] = *(const bf16x8*)(W4T + (size_t)(ct * 32 + r) * 64 + 16 * s + 8 * hh);
        const int c = (ct * 32 + r) & 127;
        const float delta = -3.0701134573253946f + (-15.350567286626973f + 3.0701134573253946f) * ((float)c * (1.0f / 127.0f));
        const float dl = -fabsf(delta) * (1.0f / (float)(L - 1));
        bf16x8 afc[2][4];
#pragma unroll
        for (int w = 0; w < 2; ++w)
#pragma unroll
            for (int s = 0; s < 4; ++s) afc[w][s] = *(const bf16x8*)(H3 + (size_t)(tg * 512 + 32 * w + r) * 64 + 16 * s + 8 * hh);
        for (int tt = 0; tt < 8; ++tt) {
            const int t0 = tg * 512 + tt * 64;
            const int tn = tg * 512 + (tt < 7 ? tt + 1 : tt) * 64;
            bf16x8 afn[2][4];
#pragma unroll
            for (int w = 0; w < 2; ++w)
#pragma unroll
                for (int s = 0; s < 4; ++s) afn[w][s] = *(const bf16x8*)(H3 + (size_t)(tn + 32 * w + r) * 64 + 16 * s + 8 * hh);
#pragma unroll
            for (int w = 0; w < 2; ++w) {
                f32x16 acc;
#pragma unroll
                for (int i = 0; i < 16; ++i) acc[i] = 0.f;
#pragma unroll
                for (int s = 0; s < 4; ++s) acc = __builtin_amdgcn_mfma_f32_32x32x16_bf16(afc[w][s], bf[s], acc, 0, 0, 0);
#pragma unroll
                for (int g = 0; g < 4; ++g) {
                    const int tl = 32 * w + 8 * g + 4 * hh; float v[4];
#pragma unroll
                    for (int e = 0; e < 4; ++e) v[e] = acc[4 * g + e] * __expf(dl * (float)(t0 + tl + e)) * 256.0f;
                    u32x2 pk; pk.x = pack_h2(v[0], v[1]); pk.y = pack_h2(v[2], v[3]);
                    *(u32x2*)(wl + r * 144 + tl * 2) = pk;
                }
            }
            asm volatile("s_waitcnt lgkmcnt(0)" ::: "memory"); __builtin_amdgcn_wave_barrier();
#pragma unroll
            for (int q = 0; q < 4; ++q) {
                const int col = q * 8 + (lane >> 3), ch = lane & 7;
                const u32x4 v = *(const u32x4*)(wl + col * 144 + ch * 16);
                *(u32x4*)(H + (size_t)(ct * 32 + col) * L + t0 + ch * 8) = v;
            }
            asm volatile("s_waitcnt lgkmcnt(0)" ::: "memory"); __builtin_amdgcn_wave_barrier();
#pragma unroll
            for (int w = 0; w < 2; ++w)
#pragma unroll
                for (int s = 0; s < 4; ++s) afc[w][s] = afn[w][s];
        }
    }
    __syncthreads();
}
DV void wfold_gemm(const Params& p) {
    const int tid = threadIdx.x, lane = tid & 63, wid = tid >> 6, G = gridDim.x;
    const float* TF = (const float*)(p.ws + WS_TF); bf16_t* W1T = (bf16_t*)(p.ws + WS_W1T);
    const int r = lane & 31, hh = lane >> 5;
    for (int task = blockIdx.x * 8 + wid; task < 4096; task += G * 8) {
        const int kt = task & 63, dt = (task >> 6) & 15, g = task >> 10; const int part = dt >> 3, d0 = (dt & 7) * 32;
        const float* ap = TF + (((size_t)g * 2 + part) * 256 + hh) * 256 + d0 + r;
        const int k = kt * 32 + r;
        const float* bp = (const float*)(p.ws + WS_WFT) + (size_t)(g * 256 + hh) * DM + k;
        f32x16 acc;
#pragma unroll
        for (int i = 0; i < 16; ++i) acc[i] = 0.f;
#pragma unroll 8
        for (int c0 = 0; c0 < 256; c0 += 2) acc = __builtin_amdgcn_mfma_f32_32x32x2f32(ap[(size_t)c0 * 256], bp[(size_t)c0 * DM], acc, 0, 0, 0);
#pragma unroll
        for (int i = 0; i < 16; ++i) { const int row = (i & 3) + 8 * (i >> 2) + 4 * hh;
            W1T[(size_t)(3072 + part * 1024 + g * 256 + d0 + row) * DM + k] = (bf16_t)f2bf(acc[i]); }
    }
}

struct KfRaw { u32x4 a0, a1, b0, b1; _Float16 nxt; };
template <int NB> DV void kf_load(const Params& p, const _Float16* H, int task, int tid, KfRaw (&raw)[2]) {
    constexpr int L = 1 << NB, NSEQ = (NB == 14) ? 1 : 2;
#pragma unroll
    for (int u = 0; u < 2; ++u) {
        const int ch = tid + u * NTHR, q = ch / (L / 16), j = ch % (L / 16);
        const int row = task * NSEQ + q, o = row >> 10, c = row & 1023;
        const _Float16* hf = H + (size_t)((o * 2 + 0) * 1024 + c) * L; const _Float16* hb = H + (size_t)((o * 2 + 1) * 1024 + c) * L;
        raw[u].a0 = ldnt4(hf + 16 * j); raw[u].a1 = ldnt4(hf + 16 * j + 8);
        raw[u].b0 = ldnt4(hb + 16 * j); raw[u].b1 = ldnt4(hb + 16 * j + 8);
        raw[u].nxt = (16 * j + 16 < L) ? hb[16 * j + 16] : (_Float16)0.f;
    }
}
template <int NB> DV void kf_phase(const Params& p, float2* fl, const _Float16* H, uint2* KF) {
    constexpr int L = 1 << NB, NSEQ = (NB == 14) ? 1 : 2, SLOTS = L / 2;
    static_assert((NSEQ * (L / 16)) / NTHR == 2, "chunk geometry");
    const int tid = threadIdx.x, G = gridDim.x;
    KfRaw raw[2];
    if ((int)blockIdx.x < 2048 / NSEQ) kf_load<NB>(p, H, blockIdx.x, tid, raw);
    for (int task = blockIdx.x; task < 2048 / NSEQ; task += G) {
#pragma unroll
        for (int u = 0; u < 2; ++u) {
            const int ch = tid + u * NTHR, q = ch / (L / 16), j = ch % (L / 16);
            const int row = task * NSEQ + q, o = row >> 10, c = row & 1023;
            const float skip = p.in[I_SKIP][o * 1024 + c];
            const int base = q * L;
            const unsigned aw[8] = {raw[u].a0.x, raw[u].a0.y, raw[u].a0.z, raw[u].a0.w, raw[u].a1.x, raw[u].a1.y, raw[u].a1.z, raw[u].a1.w};
#pragma unroll
            for (int e = 0; e < 8; ++e) { float x = h_lo(aw[e]) * (1.0f / 256.0f), y = h_hi(aw[e]) * (1.0f / 256.0f); if (j == 0 && e == 0) x += skip; fl[LPAD(base + 8 * j + e)] = make_float2(x, y); }
            const unsigned bw[8] = {raw[u].b0.x, raw[u].b0.y, raw[u].b0.z, raw[u].b0.w, raw[u].b1.x, raw[u].b1.y, raw[u].b1.z, raw[u].b1.w};
            const float nxt = (float)raw[u].nxt * (1.0f / 256.0f);
#pragma unroll
            for (int a = 0; a < 8; ++a) { const float y = h_hi(bw[a]) * (1.0f / 256.0f); const float x = (a < 7) ? h_lo(bw[a + 1]) * (1.0f / 256.0f) : nxt;
                fl[LPAD(base + L - 8 * j - 1 - a)] = make_float2(x, y); }
        }
        __syncthreads();
        if (NB == 14) { fft_pass<5, 9, false>(fl, tid); __syncthreads(); fft_pass<5, 4, false>(fl, tid); __syncthreads(); }
        else { fft_pass<5, 8, false>(fl, tid); __syncthreads(); fft_pass<4, 4, false>(fl, tid); __syncthreads(); }
        kf_load<NB>(p, H, (task + G < 2048 / NSEQ) ? task + G : task, tid, raw);
        kf_mid<NB, NSEQ>(fl, tid, KF + (size_t)(task * NSEQ) * SLOTS, KF + (size_t)(task * NSEQ + NSEQ - 1) * SLOTS);
        __syncthreads();
    }
}

template <int NB> DV void fft_fwd(float2* fl, int tid) {
    if (NB == 14) { fft_pass<5, 9, false>(fl, tid); __syncthreads(); fft_pass<5, 4, false>(fl, tid); __syncthreads(); fft_pass<4, 0, false>(fl, tid); __syncthreads(); }
    else { fft_pass<5, 8, false>(fl, tid); __syncthreads(); fft_pass<4, 4, false>(fl, tid); __syncthreads(); fft_pass<4, 0, false>(fl, tid); __syncthreads(); }
}
template <int NB> DV void fft_inv(float2* fl, int tid) {
    if (NB == 14) { fft_pass<4, 0, true>(fl, tid); __syncthreads(); fft_pass<5, 4, true>(fl, tid); __syncthreads(); fft_pass<5, 9, true>(fl, tid); __syncthreads(); }
    else { fft_pass<4, 0, true>(fl, tid); __syncthreads(); fft_pass<4, 4, true>(fl, tid); __syncthreads(); fft_pass<5, 8, true>(fl, tid); __syncthreads(); }
}
template <int NB> DV void fft_fwd_zh(float2* fl, int tid) {
    if (NB == 14) { fft_pass<5, 9, false, true>(fl, tid); __syncthreads(); fft_pass<5, 4, false>(fl, tid); __syncthreads(); fft_pass<4, 0, false>(fl, tid); __syncthreads(); }
    else { fft_pass<5, 8, false, true>(fl, tid); __syncthreads(); fft_pass<4, 4, false>(fl, tid); __syncthreads(); fft_pass<4, 0, false>(fl, tid); __syncthreads(); }
}
template <int NB> DV void fft_inv_lh(float2* fl, int tid) {
    if (NB == 14) { fft_pass<4, 0, true>(fl, tid); __syncthreads(); fft_pass<5, 4, true>(fl, tid); __syncthreads(); fft_pass<5, 9, true, true>(fl, tid); __syncthreads(); }
    else { fft_pass<4, 0, true>(fl, tid); __syncthreads(); fft_pass<4, 4, true>(fl, tid); __syncthreads(); fft_pass<5, 8, true, true>(fl, tid); __syncthreads(); }
}

struct ScRaw { u32x4 a0, a1; unsigned short lo, hi; };
DV ScRaw sc_load(const bf16_t* rowp  , int tl, int L) {
    ScRaw r; r.a0 = ldnt4(rowp + tl); r.a1 = ldnt4(rowp + tl + 8);
    r.lo = tl > 0 ? rowp[tl - 1] : (unsigned short)0; r.hi = (tl + 16 < L) ? rowp[tl + 16] : (unsigned short)0; return r;
}
DV void sc_compute(const ScRaw& r, float w0, float w1, float w2, float b, float (&v)[16]) {
    const unsigned aw[8] = {r.a0.x, r.a0.y, r.a0.z, r.a0.w, r.a1.x, r.a1.y, r.a1.z, r.a1.w};
    float u[18];
    u[0] = bf2f(r.lo); u[17] = bf2f(r.hi);
#pragma unroll
    for (int e = 0; e < 8; ++e) { u[1 + 2 * e] = bf2f(aw[e] & 0xffffu); u[2 + 2 * e] = bf2f(aw[e] >> 16); }
#pragma unroll
    for (int e = 0; e < 16; ++e) v[e] = u[e] * w0 + u[e + 1] * w1 + u[e + 2] * w2 + b;
}
DV void short_conv16(const bf16_t* rowp, int tl, int L, float w0, float w1, float w2, float b, float (&v)[16]) { const ScRaw r = sc_load(rowp, tl, L); sc_compute(r, w0, w1, w2, b, v); }

template <int NB> DV void hyena_task(const Params& p, float2* fl, int c, const uint2* KF, int tok0) {
    constexpr int L = 1 << NB, NSEQ = (NB == 14) ? 1 : 2, SLOTS = L / 2;
    int tid = threadIdx.x; asm volatile("" : "+v"(tid));
    bf16_t* PT = (bf16_t*)(p.ws + WS_B);
    const float* cw = p.in[I_CONVW]; const float* cb = p.in[I_CONVB];
#pragma unroll
    for (int q = 0; q < NSEQ; ++q) {
        const bf16_t* rp = PT + (size_t)(2048 + c) * NTOK + tok0 + q * L; const int col = 2048 + c;
        const float w0 = cw[col], w1 = cw[3072 + col], w2 = cw[6144 + col], b = cb[col];
        for (int j = tid; j < L / 16; j += NTHR) {
            float v[16]; short_conv16(rp, 16 * j, L, w0, w1, w2, b, v);
#pragma unroll
            for (int e = 0; e < 8; ++e) fl[LPAD(q * L + 8 * j + e)] = make_float2(v[2 * e], v[2 * e + 1]);
        }
    }
    __syncthreads();
#pragma unroll 1
    for (int o = 0; o < 2; ++o) {
        if (NB == 14) { fft_pass<5, 9, false, true>(fl, tid); __syncthreads(); fft_pass<5, 4, false>(fl, tid); __syncthreads(); }
        else { fft_pass<5, 8, false, true>(fl, tid); __syncthreads(); fft_pass<4, 4, false>(fl, tid); __syncthreads(); }
        uint2 slots[16];
        kf_prefetch<NB, NSEQ>(KF + (size_t)(o * 1024 + c) * SLOTS, tid, slots);
        conv_mid<NB, NSEQ>(fl, tid, slots);
        __syncthreads();
        if (NB == 14) { fft_pass<5, 4, true>(fl, tid); __syncthreads(); }
        else { fft_pass<4, 4, true>(fl, tid); __syncthreads(); }
        asm volatile("" : "+v"(tid));
        const int col = o * 1024 + c;
        const float w0 = cw[col], w1 = cw[3072 + col], w2 = cw[6144 + col], b = cb[col];
        constexpr int NCH = (NSEQ * (L / 16)) / NTHR;
        static_assert(NCH == 2, "chunk geometry");
        ScRaw raw[NCH];
#pragma unroll
        for (int u = 0; u < NCH; ++u) { const int ch = tid + u * NTHR, q = ch / (L / 16), j = ch % (L / 16); raw[u] = sc_load(PT + (size_t)col * NTOK + tok0 + q * L, 16 * j, L); }
        if (NB == 14) fft_pass<5, 9, true, true>(fl, tid); else fft_pass<5, 8, true, true>(fl, tid);
        __syncthreads();
#pragma unroll
        for (int u = 0; u < NCH; ++u) {
            const int ch = tid + u * NTHR, q = ch / (L / 16), j = ch % (L / 16);
            bf16_t* op = PT + (size_t)(2048 + c) * NTOK + tok0 + q * L;
            float v[16]; sc_compute(raw[u], w0, w1, w2, b, v);
            float y[16];
#pragma unroll
            for (int e = 0; e < 8; ++e) { const float2 z = fl[LPAD(q * L + 8 * j + e)]; y[2 * e] = z.x * v[2 * e]; y[2 * e + 1] = z.y * v[2 * e + 1]; }
            if (o == 0) {
#pragma unroll
                for (int e = 0; e < 8; ++e) fl[LPAD(q * L + 8 * j + e)] = make_float2(y[2 * e], y[2 * e + 1]);
            } else {
                u32x4 w0v, w1v;
                w0v.x = pack_bf2(y[0], y[1]); w0v.y = pack_bf2(y[2], y[3]); w0v.z = pack_bf2(y[4], y[5]); w0v.w = pack_bf2(y[6], y[7]);
                w1v.x = pack_bf2(y[8], y[9]); w1v.y = pack_bf2(y[10], y[11]); w1v.z = pack_bf2(y[12], y[13]); w1v.w = pack_bf2(y[14], y[15]);
                *(u32x4*)(op + 16 * j) = w0v; *(u32x4*)(op + 16 * j + 8) = w1v;
            }
        }
        __syncthreads();
    }
}
template <int NB> DV void fnet_task(const Params& p, float2* fl, int j, int tok0) {
    constexpr int L = 1 << NB, NSEQ = (NB == 14) ? 1 : 2;
    int tid = threadIdx.x; asm volatile("" : "+v"(tid));
    bf16_t* PT = (bf16_t*)(p.ws + WS_B);
    const float bias = p.in[I_FNB][j]; const float scale = 1.0f / sqrtf((float)L * 256.0f);
#pragma unroll
    for (int q = 0; q < NSEQ; ++q) {
        const bf16_t* rr = PT + (size_t)(3072 + j) * NTOK + tok0 + q * L; const bf16_t* ri = PT + (size_t)(4096 + j) * NTOK + tok0 + q * L;
        for (int t = tid; t < L / 8; t += NTHR) {
            const u32x4 a = *(const u32x4*)(rr + 8 * t), b = *(const u32x4*)(ri + 8 * t);
            const unsigned aw[4] = {a.x, a.y, a.z, a.w}, bw[4] = {b.x, b.y, b.z, b.w};
#pragma unroll
            for (int e = 0; e < 4; ++e) {
                fl[LPAD(q * L + (int)brev(8 * t + 2 * e, NB))] = make_float2(bf2f(aw[e] & 0xffffu), -bf2f(bw[e] & 0xffffu));
                fl[LPAD(q * L + (int)brev(8 * t + 2 * e + 1, NB))] = make_float2(bf2f(aw[e] >> 16), -bf2f(bw[e] >> 16));
            }
        }
    }
    __syncthreads();
    fft_inv<NB>(fl, tid);
#pragma unroll
    for (int q = 0; q < NSEQ; ++q) {
        bf16_t* op = PT + (size_t)(3072 + j) * NTOK + tok0 + q * L;
        for (int t = tid; t < L / 8; t += NTHR) {
            float y[8];
#pragma unroll
            for (int e = 0; e < 8; ++e) y[e] = fl[LPAD(q * L + 8 * t + e)].x * scale + bias;
            u32x4 w; w.x = pack_bf2(y[0], y[1]); w.y = pack_bf2(y[2], y[3]); w.z = pack_bf2(y[4], y[5]); w.w = pack_bf2(y[6], y[7]);
            *(u32x4*)(op + 8 * t) = w;
        }
    }
    __syncthreads();
}


template <int NB> DV void fnet2_task(const Params& p, float2* fl, int pr, int tok0, int rowbase) {
    constexpr int L = 1 << NB, NSEQ = (NB == 14) ? 1 : 2, IB = NB - 10, HN = L / 2;
    int tid = threadIdx.x; asm volatile("" : "+v"(tid));
    bf16_t* PT = (bf16_t*)(p.ws + WS_B);
    bf16_t* UR = PT + (size_t)4096 * NTOK; bf16_t* UI = UR + (size_t)1024 * 16384;
    float* NYQ = (float*)(p.ws + WS_NYQ);
#pragma unroll
    for (int q = 0; q < NSEQ; ++q) {
        const bf16_t* ra = PT + (size_t)(3072 + 2 * pr) * NTOK + tok0 + q * L; const bf16_t* rb = ra + NTOK;
        for (int t = tid; t < L / 8; t += NTHR) {
            const u32x4 a = ldnt4(ra + 8 * t), b = ldnt4(rb + 8 * t);
            const unsigned aw[4] = {a.x, a.y, a.z, a.w}, bw[4] = {b.x, b.y, b.z, b.w};
#pragma unroll
            for (int e = 0; e < 4; ++e) {
                fl[LPAD(q * L + 8 * t + 2 * e)] = make_float2(bf2f(aw[e] & 0xffffu), bf2f(bw[e] & 0xffffu));
                fl[LPAD(q * L + 8 * t + 2 * e + 1)] = make_float2(bf2f(aw[e] >> 16), bf2f(bw[e] >> 16));
            }
        }
    }
    __syncthreads();
    fft_fwd<NB>(fl, tid);
    asm volatile("" : "+v"(tid));
    v2f ua[NSEQ][1 << IB], ub[NSEQ][1 << IB];
#pragma unroll
    for (int i = 0; i < (1 << IB); ++i) {
        const int k = pair_k<NB>(tid, i);
#pragma unroll
        for (int q = 0; q < NSEQ; ++q) {
            const int base = q * L;
            if (k == 0) {
                const float2 z0 = fl[LPAD(base)], zh = fl[LPAD(base + 1)];
                ua[q][i] = (v2f){z0.x, 0.f}; ub[q][i] = (v2f){z0.y, 0.f};
                const int seq = (NB == 14) ? 0 : 1 + q;
                NYQ[seq * 1024 + 2 * pr] = zh.x; NYQ[seq * 1024 + 2 * pr + 1] = zh.y;
            } else {
                const float2 zk = fl[LPAD(base + (int)brev(k, NB))], zn = fl[LPAD(base + (int)brev(L - k, NB))];
                ua[q][i] = (v2f){0.5f * (zk.x + zn.x), 0.5f * (zk.y - zn.y)};
                ub[q][i] = (v2f){0.5f * (zk.y + zn.y), -0.5f * (zk.x - zn.x)};
            }
        }
    }
    __syncthreads();
#pragma unroll
    for (int i = 0; i < (1 << IB); ++i) {
        const int k = pair_k<NB>(tid, i);
#pragma unroll
        for (int q = 0; q < NSEQ; ++q) { ((v2f*)fl)[LPAD(q * L + k)] = ua[q][i]; ((v2f*)fl)[LPAD(q * L + HN + k)] = ub[q][i]; }
    }
    __syncthreads();
#pragma unroll
    for (int q = 0; q < NSEQ; ++q)
#pragma unroll
        for (int ch = 0; ch < 2; ++ch) {
            const size_t ro = (size_t)(2 * pr + ch) * 16384 + rowbase + q * HN;
            for (int t = tid; t < HN / 8; t += NTHR) {
                float2 z[8];
#pragma unroll
                for (int e = 0; e < 8; ++e) z[e] = fl[LPAD(q * L + ch * HN + 8 * t + e)];
                u32x4 wr_, wi_;
                wr_.x = pack_bf2(z[0].x, z[1].x); wr_.y = pack_bf2(z[2].x, z[3].x); wr_.z = pack_bf2(z[4].x, z[5].x); wr_.w = pack_bf2(z[6].x, z[7].x);
                wi_.x = pack_bf2(z[0].y, z[1].y); wi_.y = pack_bf2(z[2].y, z[3].y); wi_.z = pack_bf2(z[4].y, z[5].y); wi_.w = pack_bf2(z[6].y, z[7].y);
                *(u32x4*)(UR + ro + 8 * t) = wr_; *(u32x4*)(UI + ro + 8 * t) = wi_;
            }
        }
    __syncthreads();
}
DV void utrans_phase(const Params& p, unsigned char* lds_raw) {
    const int tid = threadIdx.x, lane = tid & 63, wid = tid >> 6, G = gridDim.x;
    unsigned* tl = (unsigned*)lds_raw;
    const bf16_t* PT = (const bf16_t*)(p.ws + WS_B);
    const bf16_t* UR = PT + (size_t)4096 * NTOK; const bf16_t* UI = UR + (size_t)1024 * 16384;
    bf16_t* AG = (bf16_t*)(p.ws + WS_B) + (size_t)1024 * NTOK;
    for (int item = blockIdx.x; item < 512; item += G) {
        const int plane = item & 1, r0 = (item >> 1) * 64; const bf16_t* src = plane ? UI : UR;
#pragma unroll
        for (int it = 0; it < 8; ++it) {
            const int id = it * NTHR + tid, q = id & 7, cp = id >> 3;
            const bf16_t* ra = src + (size_t)(2 * cp) * 16384 + r0 + 8 * q;
            const u32x4 a = ldnt4(ra), b = ldnt4(ra + 16384);
            const unsigned aw[4] = {a.x, a.y, a.z, a.w}, bw[4] = {b.x, b.y, b.z, b.w};
            const int pc = cp ^ (q << 2);
#pragma unroll
            for (int e = 0; e < 4; ++e) {
                tl[(8 * q + 2 * e) * 512 + pc] = (aw[e] & 0xffffu) | (bw[e] << 16);
                tl[(8 * q + 2 * e + 1) * 512 + pc] = (aw[e] >> 16) | (bw[e] & 0xffff0000u);
            }
        }
        __syncthreads();
#pragma unroll
        for (int tk = 0; tk < 8; ++tk) {
            const int tok = wid * 8 + tk;
#pragma unroll
            for (int j = 0; j < 2; ++j) {
                const int g4 = lane + 64 * j, g = g4 >> 5, cl = (8 * g4) & 255;
                const u32x4 d = *(const u32x4*)(tl + tok * 512 + 4 * (g4 ^ wid));
                *(u32x4*)(AG + ((size_t)g * 16384 + r0 + tok) * 512 + plane * 256 + cl) = d;
            }
        }
        __syncthreads();
    }
}
DV void nyquist_fix(const Params& p) {
    const float* NYQ = (const float*)(p.ws + WS_NYQ); const float* TF = (const float*)(p.ws + WS_TF);
    bf16_t* YG = (bf16_t*)(p.ws + WS_B);
    for (int o = blockIdx.x * NTHR + threadIdx.x; o < 3072; o += gridDim.x * NTHR) {
        const int seq = o >> 10, col = o & 1023, g = col >> 8, d = col & 255;
        float acc = 0.f;
        for (int c = 0; c < 256; ++c) acc += NYQ[seq * 1024 + g * 256 + c] * TF[(((size_t)g * 2 + 0) * 256 + c) * 256 + d];
        const int L = seq == 0 ? LP : LS, tok0 = seq == 0 ? 0 : LP + (seq - 1) * LS;
        const float scale = seq == 0 ? (1.0f / 2048.0f) : 0.00069053396600248786f;
        YG[(size_t)(tok0 + L / 2) * 1024 + col] = (bf16_t)f2bf(acc * scale + p.in[I_FNB][col]);
    }
}

DV void gate_phase(const Params& p, unsigned char* lds_raw) {
    const int tid = threadIdx.x, lane = tid & 63, wid = tid >> 6, G = gridDim.x;
    unsigned* tl = (unsigned*)lds_raw;
    const bf16_t* PT = (const bf16_t*)(p.ws + WS_B);
    const unsigned* ZT = (const unsigned*)((const unsigned char*)p.out + OUT_ZT); unsigned* T = (unsigned*)(p.ws + WS_A);
    for (int item = blockIdx.x; item < 1024; item += G) {
        const int half = item & 1, m0 = (item >> 1) * 64;
        const unsigned* YG = (const unsigned*)(p.ws + WS_B);
        u32x4 zt[8][2];
#pragma unroll
        for (int tk = 0; tk < 8; ++tk)
#pragma unroll
            for (int j = 0; j < 2; ++j) zt[tk][j] = ldnt4(ZT + (size_t)(m0 + wid * 8 + tk) * 1024 + half * 512 + 4 * (lane + 64 * j));
        if (half == 0)
#pragma unroll
        for (int it = 0; it < 8; ++it) {
            const int id = it * NTHR + tid, q = id & 7, cp = id >> 3;
            const bf16_t* ra = PT + (size_t)(2048 + half * 1024 + 2 * cp) * NTOK + m0 + 8 * q;
            const u32x4 a = ldnt4(ra), b = ldnt4(ra + NTOK);
            const unsigned aw[4] = {a.x, a.y, a.z, a.w}, bw[4] = {b.x, b.y, b.z, b.w};
            const int pc = cp ^ (q << 2);
#pragma unroll
            for (int e = 0; e < 4; ++e) {
                tl[(8 * q + 2 * e) * 512 + pc] = (aw[e] & 0xffffu) | (bw[e] << 16);
                tl[(8 * q + 2 * e + 1) * 512 + pc] = (aw[e] >> 16) | (bw[e] & 0xffff0000u);
            }
        }
        __syncthreads();
#pragma unroll
        for (int tk = 0; tk < 8; ++tk) {
            const int tok = wid * 8 + tk; const size_t mrow = (size_t)(m0 + tok) * 1024 + half * 512;
            float pr[16]; float q = 0.f;
#pragma unroll
            for (int j = 0; j < 2; ++j) {
                const int g4 = lane + 64 * j;
                const u32x4 d = half ? ldnt4(YG + (size_t)(m0 + tok) * 512 + 4 * g4) : *(const u32x4*)(tl + tok * 512 + 4 * (g4 ^ wid)), z = zt[tk][j];
                const unsigned dw[4] = {d.x, d.y, d.z, d.w}, zw[4] = {z.x, z.y, z.z, z.w};
#pragma unroll
                for (int e = 0; e < 4; ++e) { const float v0 = bf2f(dw[e] & 0xffffu) * pg8::silu_f(bf2f(zw[e] & 0xffffu)), v1 = bf2f(dw[e] >> 16) * pg8::silu_f(bf2f(zw[e] >> 16));
                    pr[8 * j + 2 * e] = v0; pr[8 * j + 2 * e + 1] = v1; q += v0 * v0 + v1 * v1; }
            }
            q = wave_sum(q);
            const float rs = rsqrtf(q * (1.0f / 1024.0f) + 1e-6f);
#pragma unroll
            for (int j = 0; j < 2; ++j) {
                u32x4 o; o.x = pack_bf2(pr[8 * j] * rs, pr[8 * j + 1] * rs); o.y = pack_bf2(pr[8 * j + 2] * rs, pr[8 * j + 3] * rs);
                o.z = pack_bf2(pr[8 * j + 4] * rs, pr[8 * j + 5] * rs); o.w = pack_bf2(pr[8 * j + 6] * rs, pr[8 * j + 7] * rs);
                *(u32x4*)(T + mrow + 4 * (lane + 64 * j)) = o;
            }
        }
        __syncthreads();
    }
}
DV void final_phase(const Params& p) {
    const int tid = threadIdx.x, lane = tid & 63, wid = tid >> 6, G = gridDim.x;
    const bf16_t* Y = (const bf16_t*)(p.ws + WS_B); const float* fn = p.in[I_FNORM];
    for (int row0 = blockIdx.x * 8 + wid; row0 < NTOK; row0 += 2 * G * 8) {
        u32x4 yv[2][4]; f32x4 xa[2][4], xb[2][4];
#pragma unroll
        for (int u = 0; u < 2; ++u) { const int row = (row0 + u * G * 8 < NTOK) ? row0 + u * G * 8 : row0;
            const float* xr = row < LP ? p.in[I_XP] + (size_t)row * DM : p.in[I_XS] + (size_t)(row - LP) * DM;
#pragma unroll
            for (int j = 0; j < 4; ++j) { const int c = j * 512 + lane * 8; yv[u][j] = __builtin_nontemporal_load((const u32x4*)(Y + (size_t)row * DM + c)); xa[u][j] = __builtin_nontemporal_load((const f32x4*)(xr + c)); xb[u][j] = __builtin_nontemporal_load((const f32x4*)(xr + c + 4)); } }
#pragma unroll
        for (int u = 0; u < 2; ++u) { const int row = row0 + u * G * 8; if (row >= NTOK) continue;
            float r[32]; float q = 0.f;
#pragma unroll
            for (int j = 0; j < 4; ++j) { const u32x4 y = yv[u][j]; const f32x4 a = xa[u][j], b = xb[u][j];
                r[8 * j + 0] = a[0] + bf2f(y.x & 0xffffu); r[8 * j + 1] = a[1] + bf2f(y.x >> 16); r[8 * j + 2] = a[2] + bf2f(y.y & 0xffffu); r[8 * j + 3] = a[3] + bf2f(y.y >> 16);
                r[8 * j + 4] = b[0] + bf2f(y.z & 0xffffu); r[8 * j + 5] = b[1] + bf2f(y.z >> 16); r[8 * j + 6] = b[2] + bf2f(y.w & 0xffffu); r[8 * j + 7] = b[3] + bf2f(y.w >> 16);
#pragma unroll
                for (int e = 0; e < 8; ++e) q += r[8 * j + e] * r[8 * j + e]; }
            q = wave_sum(q);
            const float s = rsqrtf(q * (1.0f / DM) + 1e-6f);
            float* o = p.out + (size_t)row * DM;
#pragma unroll
            for (int j = 0; j < 4; ++j) {
                const int c = j * 512 + lane * 8; const f32x4 g0 = *(const f32x4*)(fn + c), g1 = *(const f32x4*)(fn + c + 4);
                f32x4 v0, v1;
#pragma unroll
                for (int e = 0; e < 4; ++e) { v0[e] = r[8 * j + e] * s * g0[e]; v1[e] = r[8 * j + 4 + e] * s * g1[e]; }
                __builtin_nontemporal_store(v0, (f32x4*)(o + c)); __builtin_nontemporal_store(v1, (f32x4*)(o + c + 4)); } }
    }
}

DV void mix_phase(const Params& p, unsigned char* lds_raw) {
    unsigned char* ws = p.ws; const int G = gridDim.x, bx = blockIdx.x;
    const bf16_t* AG = (const bf16_t*)(ws + WS_B) + (size_t)1024 * NTOK; const bf16_t* B1 = (const bf16_t*)(ws + WS_BMIX); const bf16_t* B2 = B1 + 4 * 256 * 512;
#pragma unroll 1
    for (int j = 0; j < 8; ++j) { const int g = j >> 1, mir = j & 1;
        pg8::Gemm gm{AG + (size_t)g * 16384 * 512, (mir ? B2 : B1) + (size_t)g * 256 * 512, 16384, 256, 512};
        pg8::StaticOrder S; S.init(16384, 256, G, (bx + 8 * G - 64 * j) % G);
        pg8::EpiMix E{(bf16_t*)(ws + WS_B), p.in[I_FNB], g, mir};
        pg8::gemm_phase<pg8::EpiMix>((LAS unsigned char*)lds_raw, gm, S, E); }
    nyquist_fix(p);
}

__global__ void __launch_bounds__(NTHR, 2) mega(Params p) {
    extern __shared__ __attribute__((aligned(16))) unsigned char lds_raw[];
    float2* fl = (float2*)lds_raw;
    const int lo = p.ph_lo, hi = p.ph_hi, G = gridDim.x, bx = blockIdx.x;
    unsigned char* ws = p.ws;
#ifndef PH_MASK
#define PH_MASK 0x7ff
#endif
#define IN(k) (((PH_MASK >> (k)) & 1) && lo <= (k) && (k) < hi)
#define SEAM(k) do { if (IN(k) && IN((k) + 1)) xcd_barrier(bar); } while (0)
    XcdBarrier bar; bar.bar = (unsigned*)(ws + WS_BAR); bar.x = 0; bar.st = (volatile LAS unsigned*)((LAS unsigned char*)lds_raw + (LDS_BYTES - 16));
    if (hi - lo > 1) {
        if (threadIdx.x < 2) bar.st[threadIdx.x] = 0u;
        __syncthreads();
        bar = xcd_barrier_post((unsigned*)(ws + WS_BAR), bar.st);
    }
    if (lo < 0) cg::this_grid().sync();
#define PHASE(k, ...) do { if (IN(k)) { __VA_ARGS__ } SEAM(k); } while (0)
    PHASE(0, phase0(p, lds_raw););
    PHASE(1, h_gemm(p, lds_raw, (_Float16*)(ws + WS_B), 0, LP); h_gemm(p, lds_raw, (_Float16*)(ws + WS_B + (size_t)4096 * NTOK * 2), LP, LS););
    PHASE(2, kf_phase<14>(p, fl, (const _Float16*)(ws + WS_B), (uint2*)((unsigned char*)p.out + OUT_KFP)););
    PHASE(3,
        const bf16_t* XB = (const bf16_t*)(ws + WS_A); const bf16_t* W1T = (const bf16_t*)(ws + WS_W1T);
        { pg8::Gemm g{W1T, XB, 4096, NTOK, DM}; pg8::StaticOrder S; S.init(4096, NTOK, G, bx); pg8::EpiY E{(bf16_t*)(ws + WS_B), NTOK};
          pg8::gemm_phase<pg8::EpiY>((LAS unsigned char*)lds_raw, g, S, E); }
        { pg8::Gemm g{XB, W1T + (size_t)5120 * DM, NTOK, 2048, DM}; pg8::StaticOrder S; S.init(NTOK, 2048, G, bx); pg8::EpiY E{(bf16_t*)((unsigned char*)p.out + OUT_ZT), 2048};
          pg8::gemm_phase<pg8::EpiY>((LAS unsigned char*)lds_raw, g, S, E); }
    );
    PHASE(4, kf_phase<13>(p, fl, (const _Float16*)(ws + WS_B + (size_t)4096 * NTOK * 2), (uint2*)(ws + WS_A + 64 * MiB)););
    PHASE(5,
        const uint2* KFP = (const uint2*)((unsigned char*)p.out + OUT_KFP); const uint2* KFS = (const uint2*)(ws + WS_A + 64 * MiB);
        for (int c = bx; c < 1024; c += G) { hyena_task<14>(p, fl, c, KFP, 0); hyena_task<13>(p, fl, c, KFS, LP); }
        for (int j = bx; j < 512; j += G) { fnet2_task<14>(p, fl, j, 0, 0); fnet2_task<13>(p, fl, j, LP, 8192); }
    );
    PHASE(6, utrans_phase(p, lds_raw););
    PHASE(7, mix_phase(p, lds_raw););
    PHASE(8, gate_phase(p, lds_raw););
    PHASE(9,
        pg8::Gemm g{(const bf16_t*)(ws + WS_A), (const bf16_t*)(ws + WS_WOT), NTOK, DM, DM}; pg8::StaticOrder S; S.init(NTOK, DM, G, bx);
        pg8::EpiY E{(bf16_t*)(ws + WS_B), DM};
        pg8::gemm_phase<pg8::EpiY>((LAS unsigned char*)lds_raw, g, S, E);
    );
    PHASE(10, final_phase(p););
#undef PHASE
#undef IN
#undef SEAM
}

constexpr int N_PHASES = 11;
#ifndef HOST_TEST
extern "C" void kernel_launch(void* const* d_in, const int* in_sizes, int n_in, void* d_out, int out_size, void* d_ws, size_t ws_size, hipStream_t stream) {
    static int grid = 0;
    if (grid == 0) {
        if (n_in != 21 || out_size != NTOK * DM || ws_size < WS_END) { fprintf(stderr, "kernel_launch: unexpected shapes (n_in %d out %d ws %zu)\n", n_in, out_size, ws_size); grid = -1; return; }
        int dev = 0, cus = 0, per_cu = 0;
        (void)hipGetDevice(&dev); (void)hipDeviceGetAttribute(&cus, hipDeviceAttributeMultiprocessorCount, dev);
        if (hipFuncSetAttribute((const void*)mega, hipFuncAttributeMaxDynamicSharedMemorySize, LDS_BYTES) != hipSuccess) { fprintf(stderr, "kernel_launch: hipFuncSetAttribute failed\n"); grid = -1; return; }
        if (hipOccupancyMaxActiveBlocksPerMultiprocessor(&per_cu, (const void*)mega, NTHR, LDS_BYTES) != hipSuccess || per_cu < 1) { fprintf(stderr, "kernel_launch: occupancy query says %d\n", per_cu); per_cu = 1; }
        (void)hipGetLastError();
        grid = cus;
    }
    if (grid < 0) return;
    Params p{};
    for (int i = 0; i < 21; ++i) p.in[i] = (const float*)d_in[i];
    p.out = (float*)d_out; p.ws = (unsigned char*)d_ws;
#if N_LAUNCH_MODE == 1
    p.ph_lo = 0; p.ph_hi = N_PHASES;
    if (hipMemsetAsync((unsigned char*)d_ws + WS_BAR, 0, XCD_BAR_WORDS * 4, stream) != hipSuccess) { fprintf(stderr, "kernel_launch: memset of the barrier words failed\n"); return; }
    void* args[] = {&p};
    hipError_t e = hipLaunchCooperativeKernel((const void*)mega, dim3(grid), dim3(NTHR), args, LDS_BYTES, stream);
    if (e != hipSuccess) fprintf(stderr, "cooperative launch failed: %s (grid %d)\n", hipGetErrorString(e), grid);
#else
    for (int k = 0; k < N_PHASES; ++k) for (int r = 0; r < (k == PROBE_REP ? 2 : 1); ++r) { p.ph_lo = k; p.ph_hi = k + 1; hipLaunchKernelGGL(mega, dim3(grid), dim3(NTHR), LDS_BYTES, stream, p); }
#endif
}
#endif
```

```cpp
#include <hip/hip_runtime.h>
#include <hip/hip_cooperative_groups.h>
#include <cstdio>
#include <cmath>
namespace cg = cooperative_groups;

#ifndef PROBE_REP
#define PROBE_REP -1
#endif
#ifndef N_LAUNCH_MODE
#define N_LAUNCH_MODE 1
#endif

#define HD __host__ __device__ __forceinline__
#define DV __device__ __forceinline__
#define LAS __attribute__((address_space(3)))
typedef unsigned short bf16_t;
typedef short bf16x8 __attribute__((ext_vector_type(8)));
typedef float f32x4 __attribute__((ext_vector_type(4)));
typedef float f32x16 __attribute__((ext_vector_type(16)));
typedef unsigned u32x4 __attribute__((ext_vector_type(4)));
typedef unsigned u32x2 __attribute__((ext_vector_type(2)));

constexpr int DM = 2048, NTOK = 32768, LP = 16384, LS = 8192, NTHR = 512;
constexpr size_t MiB = 1ull << 20;
constexpr size_t WS_A = 0;
constexpr size_t WS_B = 128 * MiB;
constexpr size_t WS_W1T = 448 * MiB;
constexpr size_t WS_WOT = 476 * MiB;
constexpr size_t WS_RS = 484 * MiB;
constexpr size_t WS_H3 = WS_RS + 128 * 1024;
constexpr size_t WS_W4T = WS_H3 + 3 * MiB;
constexpr size_t WS_TF = WS_W4T + 512 * 1024;
constexpr size_t WS_SSQ = WS_TF + 2 * MiB;
constexpr size_t WS_BAR = WS_SSQ + 4 * MiB;
constexpr size_t WS_WFT = WS_BAR + 16384;
constexpr size_t WS_BMIX = WS_WFT;
constexpr size_t WS_NYQ = WS_SSQ;
constexpr size_t WS_END = WS_WFT + 8 * MiB;
constexpr size_t OUT_KFP = 0, OUT_ZT = 128 * MiB;
constexpr int LDS_BYTES = 139264;

HD unsigned f2bf(float f) { unsigned u = __builtin_bit_cast(unsigned, f); u += 0x7FFFu + ((u >> 16) & 1u); return u >> 16; }
HD float bf2f(unsigned b) { return __builtin_bit_cast(float, b << 16); }
HD unsigned pack_bf2(float lo, float hi) { return f2bf(lo) | (f2bf(hi) << 16); }
HD unsigned pack_h2(float lo, float hi) { _Float16 a = (_Float16)lo, b = (_Float16)hi; return (unsigned)__builtin_bit_cast(unsigned short, a) | ((unsigned)__builtin_bit_cast(unsigned short, b) << 16); }
HD float h_lo(unsigned u) { return (float)__builtin_bit_cast(_Float16, (unsigned short)(u & 0xffffu)); }
HD float h_hi(unsigned u) { return (float)__builtin_bit_cast(_Float16, (unsigned short)(u >> 16)); }
HD void sincos_rev(float rev, float& c, float& s) {
#ifdef __HIP_DEVICE_COMPILE__
    c = __builtin_amdgcn_cosf(rev); s = __builtin_amdgcn_sinf(rev);
#else
    c = cosf(6.283185307179586f * rev); s = sinf(6.283185307179586f * rev);
#endif
}
HD unsigned brev(unsigned x, int nb) { return __builtin_bitreverse32(x) >> (32 - nb); }
#define LPAD(i) ((i) + ((i) >> 5))
HD u32x4 ldnt4(const void* p) { return __builtin_nontemporal_load((const u32x4*)p); }
HD u32x2 ldnt2(const void* p) { return __builtin_nontemporal_load((const u32x2*)p); }
#define SCHED_FENCE()

HD constexpr float c32(int k) {
    return k == 0 ? 1.0f : k == 1 ? 0.98078528040323043f : k == 2 ? 0.92387953251128674f : k == 3 ? 0.83146961230254524f : k == 4 ? 0.70710678118654752f :
           k == 5 ? 0.55557023301960218f : k == 6 ? 0.38268343236508977f : k == 7 ? 0.19509032201612825f : k == 8 ? 0.0f :
           k == 9 ? -0.19509032201612825f : k == 10 ? -0.38268343236508977f : k == 11 ? -0.55557023301960218f : k == 12 ? -0.70710678118654752f :
           k == 13 ? -0.83146961230254524f : k == 14 ? -0.92387953251128674f : -0.98078528040323043f;
}
HD constexpr float s32(int k) {
    return k == 0 ? 0.0f : k == 1 ? 0.19509032201612825f : k == 2 ? 0.38268343236508977f : k == 3 ? 0.55557023301960218f : k == 4 ? 0.70710678118654752f :
           k == 5 ? 0.83146961230254524f : k == 6 ? 0.92387953251128674f : k == 7 ? 0.98078528040323043f : k == 8 ? 1.0f :
           k == 9 ? 0.98078528040323043f : k == 10 ? 0.92387953251128674f : k == 11 ? 0.83146961230254524f : k == 12 ? 0.70710678118654752f :
           k == 13 ? 0.55557023301960218f : k == 14 ? 0.38268343236508977f : 0.19509032201612825f;
}
HD constexpr int brev_c(int x, int nb) { return ((((x & 1) << 4) | ((x & 2) << 2) | (x & 4) | ((x & 8) >> 2) | ((x & 16) >> 4)) >> (5 - nb)); }

typedef float v2f __attribute__((ext_vector_type(2)));
HD v2f cmul(v2f x, v2f w) { return x * w.xx + x.yx * (v2f){-w.y, w.y}; }
template <int RL, bool ZH = false> HD void dif_regs(v2f (&x)[1 << RL]) {
    constexpr int R = 1 << RL;
#pragma unroll
    for (int q = 0; q < RL; ++q) {
        const int half = R >> (q + 1);
#pragma unroll
        for (int j = 0; j < R; ++j) {
            if (j & half) continue;
            const int k32 = ((j & (half - 1)) << q) * (32 / R);
            const v2f a = x[j], b = x[j + half];
            const bool zb = ZH && q == 0;
            x[j] = zb ? a : a + b;
            const v2f d = zb ? a : a - b;
            if (k32 == 0) x[j + half] = d;
            else if (k32 == 8) x[j + half] = (v2f){d.y, -d.x};
            else x[j + half] = cmul(d, (v2f){c32(k32), -s32(k32)});
        }
    }
}
template <int RL, bool LH = false> HD void dit_regs(v2f (&x)[1 << RL]) {
    constexpr int R = 1 << RL;
#pragma unroll
    for (int q = RL - 1; q >= 0; --q) {
        const int half = R >> (q + 1);
#pragma unroll
        for (int j = 0; j < R; ++j) {
            if (j & half) continue;
            const int k32 = ((j & (half - 1)) << q) * (32 / R);
            const v2f a = x[j], b = x[j + half];
            v2f t;
            if (k32 == 0) t = b;
            else if (k32 == 8) t = (v2f){-b.y, b.x};
            else t = cmul(b, (v2f){c32(k32), s32(k32)});
            x[j] = a + t; if (!(LH && q == 0)) x[j + half] = a - t;
        }
    }
}
template <int RL> HD void apply_tw(v2f (&x)[1 << RL], v2f t) {
    constexpr int R = 1 << RL;
    v2f p[4];
    p[0] = (v2f){1.f, 0.f}; p[1] = t; p[2] = cmul(t, t); p[3] = cmul(p[2], t);
    const v2f p4 = cmul(p[2], p[2]);
    v2f bs = p4;
#pragma unroll
    for (int a = 0; a < R / 4; ++a) {
#pragma unroll
        for (int b = 0; b < 4; ++b) {
            const int f = 4 * a + b;
            if (f == 0) continue;
            const v2f w = (a == 0) ? p[b] : (b == 0 ? bs : cmul(bs, p[b]));
            const int e = brev_c(f, RL);
            x[e] = cmul(x[e], w);
        }
        if (a > 0) bs = cmul(bs, p4);
        SCHED_FENCE();
    }
}
template <int SH> HD constexpr int poff(int e) { return (e << SH) + (SH >= 5 ? (e << (SH >= 5 ? SH - 5 : 0)) : (SH == 4 ? (e >> 1) : 0)); }
template <int RL, int SH, bool INV, bool HALF = false> HD void fft_pass(float2* lds, int tid) {
    constexpr int R = 1 << RL, NB = 16384 >> RL;
    static_assert(SH >= 4 || (SH == 0 && RL <= 5), "unsupported pass geometry");
#ifdef __HIP_DEVICE_COMPILE__
    asm volatile("" : "+v"(tid));
#endif
    static_assert(NB % NTHR == 0, "pass geometry");
#pragma unroll
    for (int it = 0; it < NB / NTHR; ++it) {
        const int b = tid + it * NTHR;
        const int lo = b & ((1 << SH) - 1), hi = b >> SH;
        const int base = (hi << (SH + RL)) | lo;
        v2f* pb = (v2f*)lds + LPAD(base);
        v2f x[R];
#pragma unroll
        for (int e = 0; e < R; ++e) x[e] = (HALF && !INV && e >= R / 2) ? (v2f){0.f, 0.f} : pb[poff<SH>(e)];
        float c = 1.f, s = 0.f;
        if (SH > 0) sincos_rev((float)lo * (1.0f / (float)(1 << (SH + RL))), c, s);
        SCHED_FENCE();
        if (!INV) { dif_regs<RL, HALF>(x); SCHED_FENCE(); if (SH > 0) apply_tw<RL>(x, (v2f){c, -s}); }
        else { if (SH > 0) apply_tw<RL>(x, (v2f){c, s}); SCHED_FENCE(); dit_regs<RL, HALF>(x); }
        SCHED_FENCE();
#pragma unroll
        for (int e = 0; e < R; ++e) if (!(HALF && INV && e >= R / 2)) pb[poff<SH>(e)] = x[e];
    }
}

template <int NB> HD int pair_k(int tid, int i) { constexpr int IB = NB - 10; return ((tid & 63) << (3 + IB)) | ((tid >> 6) << IB) | i; }
template <int NB> HD int fz_k(int tp, int item) {
    constexpr int NBB = NB - 4;
    if (tp != 0) return ((int)brev((unsigned)item, 4) << NBB) | (int)brev((unsigned)tp, NBB - 1);
    if (item < 8) return ((int)brev((unsigned)item, 4) << NBB) | (1 << (NBB - 1));
    return (item - 8) << NBB;
}
template <int NB, int NSEQ> HD void kf_pairs(float2* lds, int tid, uint2* kf0, uint2* kf1) {
    constexpr int N = 1 << NB, TPS = NTHR / NSEQ;
#ifdef __HIP_DEVICE_COMPILE__
    asm volatile("" : "+v"(tid));
#endif
    const int q = tid / TPS, tp = tid % TPS, base = q * N;
    uint2* kf = q ? kf1 : kf0;
    for (int item = 0; item < 16; ++item) {
        const int k = fz_k<NB>(tp, item);
        float wc, ws; sincos_rev((float)k * (0.5f / (float)N), wc, ws);
        uint2 o;
        if (k == 0) {
            const float2 z0 = lds[LPAD(base)], zh = lds[LPAD(base + 1)];
            o.x = pack_h2(z0.x + z0.y, z0.x - z0.y); o.y = pack_h2(zh.x, -zh.y);
        } else {
            const float2 zk = lds[LPAD(base + (int)brev(k, NB))], zn = lds[LPAD(base + (int)brev(N - k, NB))];
            const float er = 0.5f * (zk.x + zn.x), ei = 0.5f * (zk.y - zn.y);
            const float orr = 0.5f * (zk.y + zn.y), oi = -0.5f * (zk.x - zn.x);
            const float pr = wc * orr + ws * oi, pi = wc * oi - ws * orr;
            o.x = pack_h2(er + pr, ei + pi); o.y = pack_h2(er - pr, -(ei - pi));
        }
        kf[item * TPS + tp] = o;
    }
}
template <int NB, int NSEQ> HD void kf_prefetch(const uint2* kf, int tid, uint2 (&sl)[16]) {
    constexpr int TPS = NTHR / NSEQ; const int tp = tid % TPS;
#pragma unroll
    for (int i = 0; i < 16; ++i) { const u32x2 v = ldnt2(kf + i * TPS + tp); sl[i].x = v.x; sl[i].y = v.y; }
}
template <int NB> HD void pair_mix(v2f& zk, v2f& zn, float wc, float ws, uint2 sl) {
    constexpr int N = 1 << NB; const float invN = 1.0f / (float)N;
    const float k0 = h_lo(sl.x), k1 = h_hi(sl.x), k2 = h_lo(sl.y), k3 = h_hi(sl.y);
    const float er = 0.5f * (zk.x + zn.x), ei = 0.5f * (zk.y - zn.y);
    const float orr = 0.5f * (zk.y + zn.y), oi = -0.5f * (zk.x - zn.x);
    const float pr = wc * orr + ws * oi, pi = wc * oi - ws * orr;
    const float xkr = er + pr, xki = ei + pi, xnr = er - pr, xni = -(ei - pi);
    const float ykr = xkr * k0 - xki * k1, yki = xkr * k1 + xki * k0;
    const float ynr = xnr * k2 - xni * k3, yni = xnr * k3 + xni * k2;
    const float yer = 0.5f * (ykr + ynr), yei = 0.5f * (yki - yni);
    const float dr = 0.5f * (ykr - ynr), di = 0.5f * (yki + yni);
    const float yor = dr * wc - di * ws, yoi = dr * ws + di * wc;
    zk = (v2f){(yer - yoi) * invN, (yei + yor) * invN};
    zn = (v2f){(yer + yoi) * invN, (-yei + yor) * invN};
}
template <int NB, int NSEQ> HD void conv_mid(float2* lds, int tid, const uint2 (&slots)[16]) {
    constexpr int N = 1 << NB, NBB = NB - 4, TPS = NTHR / NSEQ;
    const float invN = 1.0f / (float)N;
#ifdef __HIP_DEVICE_COMPILE__
    asm volatile("" : "+v"(tid));
#endif
    const int q = tid / TPS, tp = tid % TPS, base = q * N;
    const int bA = 2 * tp, bB = tp ? (int)brev((unsigned)((1 << NBB) - (int)brev((unsigned)bA, NBB)), NBB) : 1;
    v2f* pA = (v2f*)lds + LPAD(base + 16 * bA); v2f* pB = (v2f*)lds + LPAD(base + 16 * bB);
    v2f xa[16], xb[16];
#pragma unroll
    for (int e = 0; e < 16; ++e) { xa[e] = pA[e]; xb[e] = pB[e]; }
    dif_regs<4>(xa); dif_regs<4>(xb);
    float cB, sB; sincos_rev((float)(tp ? (int)brev((unsigned)tp, NBB - 1) : (1 << (NBB - 1))) * (0.5f / (float)N), cB, sB);
#define TWC(E) (c32(E) * cB - s32(E) * sB)
#define TWS(E) (s32(E) * cB + c32(E) * sB)
    if (tp != 0) {
#pragma unroll
        for (int e = 0; e < 16; ++e) pair_mix<NB>(xa[e], xb[15 - e], TWC(brev_c(e, 4)), TWS(brev_c(e, 4)), slots[e]);
    } else {
#pragma unroll
        for (int e = 0; e < 8; ++e) pair_mix<NB>(xb[e], xb[15 - e], TWC(brev_c(e, 4)), TWS(brev_c(e, 4)), slots[e]);
        {
            const float k0 = h_lo(slots[8].x), k1 = h_hi(slots[8].x), k2 = h_lo(slots[8].y), k3 = h_hi(slots[8].y);
            const v2f z0 = xa[0], zh = xa[1];
            const float y0 = (z0.x + z0.y) * k0, yn = (z0.x - z0.y) * k1;
            xa[0] = (v2f){0.5f * (y0 + yn) * invN, 0.5f * (y0 - yn) * invN};
            const float yr = zh.x * k2 + zh.y * k3, yi = zh.x * k3 - zh.y * k2;
            xa[1] = (v2f){yr * invN, -yi * invN};
        }
#pragma unroll
        for (int E = 1; E < 8; ++E) pair_mix<NB>(xa[brev_c(E, 4)], xa[brev_c(16 - E, 4)], c32(E), s32(E), slots[8 + E]);
    }
    dit_regs<4>(xa); dit_regs<4>(xb);
#pragma unroll
    for (int e = 0; e < 16; ++e) { pA[e] = xa[e]; pB[e] = xb[e]; }
}

template <int NB> HD uint2 kf_spec(v2f zk, v2f zn, float wc, float ws) {
    const float er = 0.5f * (zk.x + zn.x), ei = 0.5f * (zk.y - zn.y);
    const float orr = 0.5f * (zk.y + zn.y), oi = -0.5f * (zk.x - zn.x);
    const float pr = wc * orr + ws * oi, pi = wc * oi - ws * orr;
    uint2 o; o.x = pack_h2(er + pr, ei + pi); o.y = pack_h2(er - pr, -(ei - pi)); return o;
}
template <int NB, int NSEQ> HD void kf_mid(float2* lds, int tid, uint2* kf0, uint2* kf1) {
    constexpr int N = 1 << NB, NBB = NB - 4, TPS = NTHR / NSEQ;
#ifdef __HIP_DEVICE_COMPILE__
    asm volatile("" : "+v"(tid));
#endif
    const int q = tid / TPS, tp = tid % TPS, base = q * N;
    uint2* kf = (q ? kf1 : kf0) + tp;
    const int bA = 2 * tp, bB = tp ? (int)brev((unsigned)((1 << NBB) - (int)brev((unsigned)bA, NBB)), NBB) : 1;
    const v2f* pA = (const v2f*)lds + LPAD(base + 16 * bA); const v2f* pB = (const v2f*)lds + LPAD(base + 16 * bB);
    v2f xa[16], xb[16];
#pragma unroll
    for (int e = 0; e < 16; ++e) { xa[e] = pA[e]; xb[e] = pB[e]; }
    dif_regs<4>(xa); dif_regs<4>(xb);
    float cB, sB; sincos_rev((float)(tp ? (int)brev((unsigned)tp, NBB - 1) : (1 << (NBB - 1))) * (0.5f / (float)N), cB, sB);
    if (tp != 0) {
#pragma unroll
        for (int e = 0; e < 16; ++e) kf[e * TPS] = kf_spec<NB>(xa[e], xb[15 - e], TWC(brev_c(e, 4)), TWS(brev_c(e, 4)));
    } else {
#pragma unroll
        for (int e = 0; e < 8; ++e) kf[e * TPS] = kf_spec<NB>(xb[e], xb[15 - e], TWC(brev_c(e, 4)), TWS(brev_c(e, 4)));
        { const v2f z0 = xa[0], zh = xa[1]; uint2 o; o.x = pack_h2(z0.x + z0.y, z0.x - z0.y); o.y = pack_h2(zh.x, -zh.y); kf[8 * TPS] = o; }
#pragma unroll
        for (int E = 1; E < 8; ++E) kf[(8 + E) * TPS] = kf_spec<NB>(xa[brev_c(E, 4)], xa[brev_c(16 - E, 4)], c32(E), s32(E));
    }
}

namespace pg8 {
constexpr int BM = 256, BK = 64, HALF = 128, HTB = HALF * BK * 2, STAGE_BYTES = 8 * HTB, NXCD = 8, WGM = 8;
__host__ __device__ __forceinline__ int lds_byte(int r, int c) { const int st = (r >> 4) * 2 + (c >> 5), rr = r & 15, cc = c & 31, ob = rr * 64 + cc * 2; return st * 1024 + (ob ^ (((ob >> 9) & 1) << 5)); }
__host__ __device__ __forceinline__ void stage_rc(int b, int& R, int& C) { const int st = b / 1024, sb = b % 1024, swz = sb ^ (((sb >> 9) & 1) << 5); R = (st >> 1) * 16 + swz / 64; C = (st & 1) * 32 + (swz % 64) / 2; }
__host__ __device__ __forceinline__ int perm32(int rho) { const int n = rho >> 4, i = rho & 15; return 8 * (i >> 2) + 4 * n + (i & 3); }
struct Unit { int pm, pn; };
struct Gemm { const bf16_t* A; const bf16_t* Bt; int M, N, K; };
struct StaticOrder {
    int nM, nN, nwg, G, c;
    __host__ __device__ void init(int M, int N, int G_, int c_) { nM = M / BM; nN = N / BM; nwg = nM * nN; G = G_; c = c_; }
    __host__ __device__ bool next(int i, Unit& u) const {
        const long L = (long)i * G + c; if (L >= nwg) return false;
        int wgid = (int)L; { const int q = nwg / NXCD, r = nwg % NXCD, xcd = wgid % NXCD, off = wgid / NXCD; wgid = (xcd < r ? xcd * (q + 1) : r * (q + 1) + (xcd - r) * q) + off; }
        const int nig = WGM * nN, gid = wgid / nig, fm = gid * WGM, gsz = (nM - fm) < WGM ? (nM - fm) : WGM;
        u.pm = fm + ((wgid % nig) % gsz); u.pn = (wgid % nig) / gsz; return true;
    }
};
__device__ __forceinline__ unsigned cvt_pk_bf16(float lo, float hi) { unsigned r; asm volatile("v_cvt_pk_bf16_f32 %0, %1, %2" : "=v"(r) : "v"(lo), "v"(hi)); return r; }

template <class Epi>
__device__ __forceinline__ void gemm_phase(LAS unsigned char* lds, const Gemm g, const StaticOrder& S, const Epi& E) {
    const int tid = threadIdx.x, wid = __builtin_amdgcn_readfirstlane(tid >> 6), lane = tid & 63, wr = wid >> 2, wc = wid & 3, fr = lane & 15, fq = lane >> 4;
    const int K = g.K, nt = K / BK;
    unsigned voffA[2], voffB[2];
#pragma unroll
    for (int i = 0; i < 2; ++i) { int R, C; stage_rc(tid * 16 + i * 8192, R, C); const int Rb = Epi::PERM ? ((R & ~31) + perm32(R & 31)) : R;
        voffA[i] = (unsigned)(R * K + C) * 2u; voffB[i] = (unsigned)(Rb * K + C) * 2u; }
    const size_t kstep = (size_t)(BK * 2);
    const size_t hstep = (size_t)HALF * K * 2;
    const size_t tstep = 2 * hstep;
    const unsigned ldsw = (unsigned)wid * 1024u;
    const int aoff = lds_byte(wr * 64 + fr, fq * 8), boff = lds_byte(wc * 32 + fr, fq * 8);
#define PG8_SA(b, h) (((b) * 2 + (h)) * HTB)
#define PG8_SB(b, h) ((4 + (b) * 2 + (h)) * HTB)
#define PG8_STAGE(bufoff, gbase, voff) do { _Pragma("unroll") for (int _i = 0; _i < 2; ++_i) \
        __builtin_amdgcn_global_load_lds((const unsigned*)((const char*)(gbase) + (voff)[_i]), (LAS unsigned*)(lds + (bufoff) + ldsw + _i * 8192), 16, 0, 0); } while (0)
#define PG8_LDA(dst, b, h) do { _Pragma("unroll") for (int m = 0; m < 4; ++m) _Pragma("unroll") for (int k = 0; k < 2; ++k) dst[m][k] = *(const LAS bf16x8*)(lds + PG8_SA(b, h) + aoff + m * 2048 + k * 1024); } while (0)
#define PG8_LDB(dst, b, h) do { _Pragma("unroll") for (int n = 0; n < 2; ++n) _Pragma("unroll") for (int k = 0; k < 2; ++k) dst[n][k] = *(const LAS bf16x8*)(lds + PG8_SB(b, h) + boff + n * 2048 + k * 1024); } while (0)
#define PG8_MMA(ai, bj, At, Bt) do { __builtin_amdgcn_s_setprio(1); _Pragma("unroll") for (int m = 0; m < 4; ++m) _Pragma("unroll") for (int n = 0; n < 2; ++n) _Pragma("unroll") for (int k = 0; k < 2; ++k) \
        acc[ai][bj][m][n] = __builtin_amdgcn_mfma_f32_16x16x32_bf16(Bt[n][k], At[m][k], acc[ai][bj][m][n], 0, 0, 0); __builtin_amdgcn_s_setprio(0); } while (0)
#define PG8_WAIT_V(n) asm volatile("s_waitcnt vmcnt(" #n ")" ::: "memory")
#define PG8_WAIT_L(n) asm volatile("s_waitcnt lgkmcnt(" #n ")" ::: "memory")
#define PG8_BAR __builtin_amdgcn_s_barrier()
#define PG8_SCHED __builtin_amdgcn_sched_barrier(0)
    Unit cur, nxt; int ui = 0;
    if (!S.next(0, cur)) return;
    f32x4 acc[2][2][4][2];
#pragma unroll
    for (int a = 0; a < 2; ++a)
#pragma unroll
        for (int b = 0; b < 2; ++b)
#pragma unroll
            for (int m = 0; m < 4; ++m)
#pragma unroll
                for (int n = 0; n < 2; ++n) acc[a][b][m][n] = (f32x4){0.f, 0.f, 0.f, 0.f};
    bf16x8 At[4][2], B0[2][2], B1[2][2];
    const char* cA = (const char*)g.A + (size_t)cur.pm * tstep; const char* cB = (const char*)g.Bt + (size_t)cur.pn * tstep;
    PG8_STAGE(PG8_SB(0, 0), cB, voffB); PG8_STAGE(PG8_SA(0, 0), cA, voffA); PG8_STAGE(PG8_SB(0, 1), cB + hstep, voffB); PG8_STAGE(PG8_SA(0, 1), cA + hstep, voffA);
    if (wr == 1) PG8_BAR;
    PG8_WAIT_V(4); PG8_BAR;
    PG8_STAGE(PG8_SB(1, 0), cB + kstep, voffB); PG8_STAGE(PG8_SA(1, 0), cA + kstep, voffA); PG8_STAGE(PG8_SB(1, 1), cB + hstep + kstep, voffB);
    PG8_WAIT_V(6); PG8_BAR;
    for (;;) {
        const bool has_next = S.next(ui + 1, nxt);
        const char* nA = has_next ? (const char*)g.A + (size_t)nxt.pm * tstep : cA; const char* nB = has_next ? (const char*)g.Bt + (size_t)nxt.pn * tstep : cB;
        for (int t = 0; t < nt; t += 2) {
            const bool last = (t == nt - 2);
            const char* a1 = cA + (size_t)(t + 1) * kstep;
            const char* a2 = last ? nA : cA + (size_t)(t + 2) * kstep; const char* b2 = last ? nB : cB + (size_t)(t + 2) * kstep;
            const char* a3 = a2 + kstep; const char* b3 = b2 + kstep;
            PG8_LDB(B0, 0, 0); PG8_SCHED; PG8_LDA(At, 0, 0); PG8_STAGE(PG8_SA(1, 1), a1 + hstep, voffA);
            PG8_WAIT_L(8); PG8_BAR; PG8_WAIT_L(0); PG8_MMA(0, 0, At, B0); PG8_BAR; PG8_SCHED;
            PG8_LDB(B1, 0, 1); PG8_STAGE(PG8_SB(0, 0), b2, voffB);
            PG8_BAR; PG8_WAIT_L(0); PG8_MMA(0, 1, At, B1); PG8_BAR;
            PG8_LDA(At, 0, 1); PG8_STAGE(PG8_SA(0, 0), a2, voffA);
            PG8_BAR; PG8_WAIT_L(0); PG8_MMA(1, 0, At, B0); PG8_BAR; PG8_SCHED;
            PG8_STAGE(PG8_SB(0, 1), b2 + hstep, voffB);
            PG8_WAIT_V(6); PG8_BAR; PG8_MMA(1, 1, At, B1); PG8_BAR;
            PG8_LDB(B0, 1, 0); PG8_SCHED; PG8_LDA(At, 1, 0); PG8_STAGE(PG8_SA(0, 1), a2 + hstep, voffA);
            PG8_WAIT_L(8); PG8_BAR; PG8_WAIT_L(0); PG8_MMA(0, 0, At, B0); PG8_BAR; PG8_SCHED;
            PG8_LDB(B1, 1, 1); PG8_STAGE(PG8_SB(1, 0), b3, voffB);
            PG8_BAR; PG8_WAIT_L(0); PG8_MMA(0, 1, At, B1); PG8_BAR;
            PG8_LDA(At, 1, 1); PG8_STAGE(PG8_SA(1, 0), a3, voffA);
            PG8_BAR; PG8_WAIT_L(0); PG8_MMA(1, 0, At, B0); PG8_BAR; PG8_SCHED;
            PG8_STAGE(PG8_SB(1, 1), b3 + hstep, voffB);
            PG8_WAIT_V(6); PG8_BAR; PG8_MMA(1, 1, At, B1); PG8_BAR;
        }
        E(acc, cur, wr, wc, fr, fq);
        if (!has_next) break;
#pragma unroll
        for (int a = 0; a < 2; ++a)
#pragma unroll
            for (int b = 0; b < 2; ++b)
#pragma unroll
                for (int m = 0; m < 4; ++m)
#pragma unroll
                    for (int n = 0; n < 2; ++n) acc[a][b][m][n] = (f32x4){0.f, 0.f, 0.f, 0.f};
        cur = nxt; cA = nA; cB = nB; ++ui;
    }
    PG8_WAIT_V(0);
    if (wr == 0) PG8_BAR;
    PG8_BAR;
#undef PG8_SA
#undef PG8_SB
#undef PG8_STAGE
#undef PG8_LDA
#undef PG8_LDB
#undef PG8_MMA
#undef PG8_WAIT_V
#undef PG8_WAIT_L
#undef PG8_BAR
#undef PG8_SCHED
}

struct EpiPT {
    static constexpr bool PERM = true;
    bf16_t* O; int ldc; const float* cs;
    __device__ __forceinline__ void operator()(const f32x4 (&acc)[2][2][4][2], const Unit& u, int wr, int wc, int fr, int fq) const {
        const int row0 = u.pm * BM + wr * 64 + fr, col0 = u.pn * BM + wc * 32 + 8 * fq;
        f32x4 sv[2][2];
#pragma unroll
        for (int bj = 0; bj < 2; ++bj)
#pragma unroll
            for (int n = 0; n < 2; ++n) sv[bj][n] = *(const f32x4*)(cs + col0 + bj * HALF + 4 * n);
#pragma unroll
        for (int ai = 0; ai < 2; ++ai)
#pragma unroll
            for (int m = 0; m < 4; ++m) { bf16_t* rowp = O + (size_t)(row0 + ai * HALF + m * 16) * ldc + col0;
#pragma unroll
                for (int bj = 0; bj < 2; ++bj) { const f32x4 v0 = acc[ai][bj][m][0] * sv[bj][0], v1 = acc[ai][bj][m][1] * sv[bj][1];
                    u32x4 w; w.x = cvt_pk_bf16(v0[0], v0[1]); w.y = cvt_pk_bf16(v0[2], v0[3]); w.z = cvt_pk_bf16(v1[0], v1[1]); w.w = cvt_pk_bf16(v1[2], v1[3]);
                    *(u32x4*)(rowp + bj * HALF) = w; } }
    }
};
__device__ __forceinline__ float silu_f(float z) { return z * __builtin_amdgcn_rcpf(1.0f + __expf(-z)); }
struct EpiZT {
    static constexpr bool PERM = true;
    bf16_t* O; int ldc; const float* rs;
    __device__ __forceinline__ void operator()(const f32x4 (&acc)[2][2][4][2], const Unit& u, int wr, int wc, int fr, int fq) const {
        const int row0 = u.pm * BM + wr * 64 + fr, col0 = u.pn * BM + wc * 32 + 8 * fq;
#pragma unroll
        for (int ai = 0; ai < 2; ++ai)
#pragma unroll
            for (int m = 0; m < 4; ++m) { const int row = row0 + ai * HALF + m * 16; const float s = rs[row]; bf16_t* rowp = O + (size_t)row * ldc + col0;
#pragma unroll
                for (int bj = 0; bj < 2; ++bj) { const f32x4 v0 = acc[ai][bj][m][0] * s, v1 = acc[ai][bj][m][1] * s;
                    u32x4 w; w.x = cvt_pk_bf16(v0[0], v0[1]); w.y = cvt_pk_bf16(v0[2], v0[3]); w.z = cvt_pk_bf16(v1[0], v1[1]); w.w = cvt_pk_bf16(v1[2], v1[3]);
                    *(u32x4*)(rowp + bj * HALF) = w; } }
    }
};
struct EpiY {
    static constexpr bool PERM = true;
    bf16_t* O; int ldc;
    __device__ __forceinline__ void operator()(const f32x4 (&acc)[2][2][4][2], const Unit& u, int wr, int wc, int fr, int fq) const {
        const int row0 = u.pm * BM + wr * 64 + fr, col0 = u.pn * BM + wc * 32 + 8 * fq;
#pragma unroll
        for (int ai = 0; ai < 2; ++ai)
#pragma unroll
            for (int m = 0; m < 4; ++m) { bf16_t* rowp = O + (size_t)(row0 + ai * HALF + m * 16) * ldc + col0;
#pragma unroll
                for (int bj = 0; bj < 2; ++bj) { const f32x4 v0 = acc[ai][bj][m][0], v1 = acc[ai][bj][m][1];
                    u32x4 w; w.x = cvt_pk_bf16(v0[0], v0[1]); w.y = cvt_pk_bf16(v0[2], v0[3]); w.z = cvt_pk_bf16(v1[0], v1[1]); w.w = cvt_pk_bf16(v1[2], v1[3]);
                    *(u32x4*)(rowp + bj * HALF) = w; } }
    }
};
struct EpiMix {
    static constexpr bool PERM = true;
    bf16_t* YG; const float* bias; int g, mirror;
    __device__ __forceinline__ void operator()(const f32x4 (&acc)[2][2][4][2], const Unit& u, int wr, int wc, int fr, int fq) const {
        const int r0 = u.pm * BM;
        const int L = r0 < 8192 ? LP : LS, kb = r0 < 8192 ? 0 : (r0 < 12288 ? 8192 : 12288), tok0 = r0 < 8192 ? 0 : (r0 < 12288 ? LP : LP + LS);
        const float scale = r0 < 8192 ? (1.0f / 2048.0f) : 0.00069053396600248786f;
        const int col0 = g * 256 + wc * 32 + 8 * fq;
        f32x4 bv[2][2];
#pragma unroll
        for (int bj = 0; bj < 2; ++bj)
#pragma unroll
            for (int n = 0; n < 2; ++n) bv[bj][n] = *(const f32x4*)(bias + col0 + bj * HALF + 4 * n);
#pragma unroll
        for (int ai = 0; ai < 2; ++ai)
#pragma unroll
            for (int m = 0; m < 4; ++m) { const int k = r0 - kb + wr * 64 + fr + ai * HALF + m * 16;
                if (mirror && k == 0) continue;
                bf16_t* rowp = YG + (size_t)(tok0 + (mirror ? L - k : k)) * 1024 + col0;
#pragma unroll
                for (int bj = 0; bj < 2; ++bj) { const f32x4 v0 = acc[ai][bj][m][0] * scale + bv[bj][0], v1 = acc[ai][bj][m][1] * scale + bv[bj][1];
                    u32x4 w; w.x = cvt_pk_bf16(v0[0], v0[1]); w.y = cvt_pk_bf16(v0[2], v0[3]); w.z = cvt_pk_bf16(v1[0], v1[1]); w.w = cvt_pk_bf16(v1[2], v1[3]);
                    *(u32x4*)(rowp + bj * HALF) = w; } }
    }
};
struct EpiOut {
    static constexpr bool PERM = false;
    float* C; const float* xp; const float* xs; float* ssq;
    __device__ __forceinline__ void operator()(const f32x4 (&acc)[2][2][4][2], const Unit& u, int wr, int wc, int fr, int fq) const {
        const int row0 = u.pm * BM + wr * 64 + fr, col0 = u.pn * BM + wc * 32 + 4 * fq;
#pragma unroll
        for (int ai = 0; ai < 2; ++ai)
#pragma unroll
            for (int m = 0; m < 4; ++m) { const int row = row0 + ai * HALF + m * 16;
                const float* xr = (row < LP ? xp + (size_t)row * DM : xs + (size_t)(row - LP) * DM) + col0; float* cr = C + (size_t)row * DM + col0; float q = 0.f;
#pragma unroll
                for (int bj = 0; bj < 2; ++bj)
#pragma unroll
                    for (int n = 0; n < 2; ++n) { const f32x4 o = acc[ai][bj][m][n] + *(const f32x4*)(xr + bj * HALF + n * 16); *(f32x4*)(cr + bj * HALF + n * 16) = o;
                        q += (o[0] * o[0] + o[1] * o[1]) + (o[2] * o[2] + o[3] * o[3]); }
                q += __shfl_xor(q, 16); q += __shfl_xor(q, 32);
                if (fq == 0) ssq[(size_t)row * 32 + u.pn * 4 + wc] = q; }
    }
};
}


#define XB_TMO      128
#define XB_XCNT(j)  (256  + 64 * (j))
#define XB_XSUB(j)  (1280 + 64 * (j))
#define XB_XGEN(j)  (2304 + 64 * (j))
#define XB_TOP      3328
#define XB_TOPGEN   3392
#define XCD_BAR_WORDS 3456
#define XB_SPIN_CAP (1u << 20)
DV unsigned xb_ld(unsigned* p)              { return __hip_atomic_load(p, __ATOMIC_RELAXED, __HIP_MEMORY_SCOPE_AGENT); }
DV unsigned xb_add(unsigned* p, unsigned v) { return __hip_atomic_fetch_add(p, v, __ATOMIC_RELAXED, __HIP_MEMORY_SCOPE_AGENT); }
DV unsigned xb_xcc_id() { return (unsigned)__builtin_amdgcn_s_getreg((3 << 11) | 20) & 0xFu; }
#define XB_SPIN(cond, bar) do { unsigned _sp = 0; while (cond) { __builtin_amdgcn_s_sleep(1); \
    if ((++_sp & 255u) == 0u) { if (xb_ld(&(bar)[XB_TMO])) break; if (_sp > XB_SPIN_CAP) { atomicAdd(&(bar)[XB_TMO], 1u); break; } } } } while (0)
struct XcdBarrier { unsigned* bar; unsigned x; volatile LAS unsigned* st; };
DV XcdBarrier xcd_barrier_post(unsigned* bar, volatile LAS unsigned* st) {
    XcdBarrier b; b.bar = bar; b.x = xb_xcc_id(); b.st = st;
    if (threadIdx.x == 0) (void)xb_add(&bar[XB_XCNT(b.x)], 1u);
    return b;
}
DV void xcd_barrier_complete(unsigned* bar, unsigned x, unsigned& nloc, unsigned& nx) {
    const unsigned G = gridDim.x * gridDim.y * gridDim.z;
    unsigned sum, cnt, mine, sp = 0u;
    for (;;) {
        sum = 0u; cnt = 0u; mine = 0u;
#pragma unroll
        for (unsigned j = 0; j < 16; ++j) { const unsigned c = xb_ld(&bar[XB_XCNT(j)]); sum += c; cnt += (c > 0u) ? 1u : 0u; mine = (j == x) ? c : mine; }
        if (sum == G) break;
        __builtin_amdgcn_s_sleep(1);
        if ((++sp & 255u) == 0u) { if (xb_ld(&bar[XB_TMO])) break; if (sp > XB_SPIN_CAP) { atomicAdd(&bar[XB_TMO], 1u); break; } }
    }
    nloc = mine > 0u ? mine : 1u; nx = cnt > 0u ? cnt : 1u;
}
DV void xcd_barrier(const XcdBarrier& b) {
    asm volatile("s_waitcnt vmcnt(0)" ::: "memory");
    __syncthreads();
    if (threadIdx.x == 0) {
        unsigned* bar = b.bar;
        __builtin_amdgcn_s_waitcnt(0);
        unsigned nloc = b.st[0], nx = b.st[1];
        if (nloc == 0u) { xcd_barrier_complete(bar, b.x, nloc, nx); b.st[0] = nloc; b.st[1] = nx; }
        const unsigned old = xb_add(&bar[XB_XSUB(b.x)], 1u);
        const unsigned gen = old / nloc;
        if (old + 1u == (gen + 1u) * nloc) {
            __builtin_amdgcn_fence(__ATOMIC_RELEASE, "agent");
            asm volatile("s_waitcnt vmcnt(0)" ::: "memory");
            const unsigned og = xb_add(&bar[XB_TOP], 1u);
            const unsigned tg = og / nx;
            if (og + 1u == (tg + 1u) * nx) xb_add(&bar[XB_TOPGEN], 1u);
            else XB_SPIN(xb_ld(&bar[XB_TOPGEN]) == tg, bar);
            __builtin_amdgcn_fence(__ATOMIC_ACQUIRE, "agent");
            xb_add(&bar[XB_XGEN(b.x)], 1u);
            asm volatile("s_waitcnt vmcnt(0)" ::: "memory");
        } else {
            XB_SPIN(xb_ld(&bar[XB_XGEN(b.x)]) == gen, bar);
            __builtin_amdgcn_fence(__ATOMIC_ACQUIRE, "agent");
            asm volatile("s_waitcnt vmcnt(0)" ::: "memory");
        }
    }
    __syncthreads();
}

struct Params { const float* in[21]; float* out; unsigned char* ws; int ph_lo, ph_hi; };
enum { I_XP = 0, I_XS, I_NORMG, I_WIN, I_CONVW, I_CONVB, I_FW1, I_FB1, I_FW2, I_FB2, I_FW3, I_FB3, I_FW4, I_FREQ, I_SKIP, I_FNW, I_FNB, I_NHY, I_NFN, I_WOUT, I_FNORM };

DV float wave_sum(float v) {
#pragma unroll
    for (int o = 32; o > 0; o >>= 1) v += __shfl_xor(v, o);
    return v;
}

DV void transpose_tile(float* tl, const float* src, int ld, int k0, int c0, const float* sc, bf16_t* dst, int row0, int ldd, int lane) {
#pragma unroll
    for (int it = 0; it < 16; ++it) {
        const int k = it * 4 + (lane >> 4), cc = (lane & 15) * 4; const f32x4 a = *(const f32x4*)(src + (size_t)(k0 + k) * ld + c0 + cc);
        const float f = sc ? sc[k0 + k] : 1.0f; float* t = tl + k * 65 + cc; t[0] = a[0] * f; t[1] = a[1] * f; t[2] = a[2] * f; t[3] = a[3] * f;
    }
    asm volatile("s_waitcnt lgkmcnt(0)" ::: "memory"); __builtin_amdgcn_wave_barrier();
#pragma unroll
    for (int kc = 0; kc < 8; ++kc) {
        const int kk = kc * 8; u32x4 w;
        w.x = pack_bf2(tl[(kk + 0) * 65 + lane], tl[(kk + 1) * 65 + lane]); w.y = pack_bf2(tl[(kk + 2) * 65 + lane], tl[(kk + 3) * 65 + lane]);
        w.z = pack_bf2(tl[(kk + 4) * 65 + lane], tl[(kk + 5) * 65 + lane]); w.w = pack_bf2(tl[(kk + 6) * 65 + lane], tl[(kk + 7) * 65 + lane]);
        *(u32x4*)(dst + (size_t)(row0 + lane) * ldd + k0 + kk) = w;
    }
    asm volatile("s_waitcnt lgkmcnt(0)" ::: "memory"); __builtin_amdgcn_wave_barrier();
}

DV void transpose_tile_f32(float* tl, const float* src, int ld, int k0, int c0, const float* sc, float* dst, int row0, int ldd, int lane) {
#pragma unroll
    for (int it = 0; it < 16; ++it) {
        const int k = it * 4 + (lane >> 4), cc = (lane & 15) * 4; const f32x4 a = *(const f32x4*)(src + (size_t)(k0 + k) * ld + c0 + cc);
        const float f = sc ? sc[k0 + k] : 1.0f; float* t = tl + k * 65 + cc; t[0] = a[0] * f; t[1] = a[1] * f; t[2] = a[2] * f; t[3] = a[3] * f;
    }
    asm volatile("s_waitcnt lgkmcnt(0)" ::: "memory"); __builtin_amdgcn_wave_barrier();
#pragma unroll
    for (int kc = 0; kc < 16; ++kc) {
        const int kk = kc * 4; f32x4 w; w[0] = tl[(kk + 0) * 65 + lane]; w[1] = tl[(kk + 1) * 65 + lane]; w[2] = tl[(kk + 2) * 65 + lane]; w[3] = tl[(kk + 3) * 65 + lane];
        *(f32x4*)(dst + (size_t)(row0 + lane) * ldd + k0 + kk) = w;
    }
    asm volatile("s_waitcnt lgkmcnt(0)" ::: "memory"); __builtin_amdgcn_wave_barrier();
}

DV void phase0(const Params& p, unsigned char* lds_raw) {
    const int tid = threadIdx.x, lane = tid & 63, wid = tid >> 6, G0 = gridDim.x, bx0 = blockIdx.x;
    unsigned char* ws = p.ws;
    const int NTF = G0 > 32 ? 16 : 0;
    const bool tf_role = NTF == 0 || bx0 < NTF, common_role = NTF == 0 || bx0 >= NTF;
    const int G = common_role ? G0 - NTF : G0, bx = common_role ? bx0 - NTF : bx0;
    if (common_role) {
        bf16_t* XB = (bf16_t*)(ws + WS_A);
        for (int row0 = bx * 8 + wid; row0 < NTOK; row0 += 2 * G * 8) {
            const int rows[2] = {row0, row0 + G * 8};
            f32x4 va[2][4], vb[2][4];
#pragma unroll
            for (int u = 0; u < 2; ++u) { const int row = rows[u] < NTOK ? rows[u] : row0;
                const float* xr = row < LP ? p.in[I_XP] + (size_t)row * DM : p.in[I_XS] + (size_t)(row - LP) * DM;
#pragma unroll
                for (int j = 0; j < 4; ++j) { const int c = j * 512 + lane * 8; va[u][j] = __builtin_nontemporal_load((const f32x4*)(xr + c)); vb[u][j] = __builtin_nontemporal_load((const f32x4*)(xr + c + 4)); } }
#pragma unroll
            for (int u = 0; u < 2; ++u) { const int row = rows[u]; if (row >= NTOK) continue;
                float q = 0.f;
#pragma unroll
                for (int j = 0; j < 4; ++j) { const f32x4 a = va[u][j], b = vb[u][j];
                    q += (a[0] * a[0] + a[1] * a[1]) + (a[2] * a[2] + a[3] * a[3]) + (b[0] * b[0] + b[1] * b[1]) + (b[2] * b[2] + b[3] * b[3]); }
                q = wave_sum(q);
                const float rs = rsqrtf(q * (1.0f / DM) + 1e-6f);
#pragma unroll
                for (int j = 0; j < 4; ++j) { const int c = j * 512 + lane * 8; const f32x4 a = va[u][j] * rs, b = vb[u][j] * rs;
                    u32x4 w; w.x = pack_bf2(a[0], a[1]); w.y = pack_bf2(a[2], a[3]); w.z = pack_bf2(b[0], b[1]); w.w = pack_bf2(b[2], b[3]);
                    *(u32x4*)(XB + (size_t)row * DM + c) = w; } }
        }
    }
    if (common_role) {
        float* W1 = (float*)lds_raw; float* W2 = W1 + 33 * 64; float* W3 = W2 + 64 * 64; float* B1 = W3 + 64 * 64; float* B2 = B1 + 64; float* B3 = B2 + 64; float* FR = B3 + 64;
        for (int i = tid; i < 33 * 64; i += NTHR) W1[i] = p.in[I_FW1][i];
        for (int i = tid; i < 64 * 64; i += NTHR) { W2[i] = p.in[I_FW2][i]; W3[i] = p.in[I_FW3][i]; }
        if (tid < 64) { B1[tid] = p.in[I_FB1][tid]; B2[tid] = p.in[I_FB2][tid]; B3[tid] = p.in[I_FB3][tid]; FR[tid] = p.in[I_FREQ][tid]; }
        __syncthreads();
        bf16_t* H3 = (bf16_t*)(ws + WS_H3);
        const float fr = FR[lane] * 0.15915494309189535f;
        for (int pos = bx * 8 + wid; pos < LP + LS; pos += G * 8) {
            const int L = pos < LP ? LP : LS, n = pos < LP ? pos : pos - LP;
            float z;
            if (lane == 0) z = (float)n / (float)(L - 1);
            else {
                const int j = (lane - 1) & 15; const float f = 1e-4f + (float)j * ((15.0f - 1e-4f) / 15.0f);
                const float rev = (float)n * f / (float)L;
                z = (lane <= 16) ? __builtin_amdgcn_cosf(rev) : -__builtin_amdgcn_sinf(rev);
            }
            float a = B1[lane];
#pragma unroll
            for (int i = 0; i < 33; ++i) a += __builtin_bit_cast(float, __builtin_amdgcn_readlane(__builtin_bit_cast(int, z), i)) * W1[i * 64 + lane];
            float h = __builtin_amdgcn_sinf(fr * a);
            a = B2[lane];
#pragma unroll
            for (int i = 0; i < 64; ++i) a += __builtin_bit_cast(float, __builtin_amdgcn_readlane(__builtin_bit_cast(int, h), i)) * W2[i * 64 + lane];
            h = __builtin_amdgcn_sinf(fr * a);
            a = B3[lane];
#pragma unroll
            for (int i = 0; i < 64; ++i) a += __builtin_bit_cast(float, __builtin_amdgcn_readlane(__builtin_bit_cast(int, h), i)) * W3[i * 64 + lane];
            h = __builtin_amdgcn_sinf(fr * a);
            H3[(size_t)pos * 64 + lane] = (bf16_t)f2bf(h);
        }
        __syncthreads();
    }
    if (common_role) {
        float* tl = (float*)lds_raw + wid * (64 * 65);
        bf16_t* W1T = (bf16_t*)(ws + WS_W1T); bf16_t* WOT = (bf16_t*)(ws + WS_WOT); bf16_t* W4T = (bf16_t*)(ws + WS_W4T);
        for (int t = bx * 8 + wid; t < 32 * 96 + 32 * 32 + 64; t += G * 8) {
            if (t < 32 * 96) {
                const int kt = t & 31, ct = t >> 5; const int pc = ct * 64;
                const int row = pc < 3072 ? pc : (pc < 4096 ? 5120 + (pc - 3072) : (pc < 5120 ? 3072 + (pc - 4096) : 6144 + (pc - 5120)));
                transpose_tile(tl, p.in[I_WIN], 6144, kt * 64, pc, p.in[I_NORMG], W1T, row, DM, lane);
            } else if (t < 32 * 96 + 32 * 32) {
                const int u = t - 32 * 96, kt = u & 31, ct = u >> 5; const float* sc = kt < 16 ? p.in[I_NHY] : p.in[I_NFN] - 1024;
                transpose_tile(tl, p.in[I_WOUT], DM, kt * 64, ct * 64, sc, WOT, ct * 64, DM, lane);
            } else { const int u = t - 32 * 96 - 32 * 32; transpose_tile(tl, p.in[I_FW4], 4096, 0, u * 64, nullptr, W4T, u * 64, 64, lane); }
        }
        __syncthreads();
    }
    {
        float2* fl = (float2*)lds_raw; float* TF = (float*)(ws + WS_TF);
        for (int t = bx0; tf_role && t < 16; t += (NTF ? NTF : G0)) {
            const int g = t >> 2, d0 = (t & 3) * 64;
            for (int e = tid; e < 16384; e += NTHR) { const int i = e & 63, f = e >> 6; fl[LPAD(i * 256 + f)] = make_float2(p.in[I_FNW][((size_t)g * 256 + f) * 256 + d0 + i], 0.f); }
            __syncthreads();
            fft_pass<4, 4, false>(fl, tid); __syncthreads();
            fft_pass<4, 0, false>(fl, tid); __syncthreads();
            for (int e = tid; e < 16384; e += NTHR) { const int i = e & 63, c = e >> 6; const float2 v = fl[LPAD(i * 256 + (int)brev(c, 8))];
                TF[(((size_t)g * 2 + 0) * 256 + c) * 256 + d0 + i] = v.x; TF[(((size_t)g * 2 + 1) * 256 + c) * 256 + d0 + i] = v.y; }
            { bf16_t* B1 = (bf16_t*)(ws + WS_BMIX); bf16_t* B2 = B1 + 4 * 256 * 512;
              for (int e = tid; e < 16384; e += NTHR) { const int c = e & 255, i = e >> 8; const float2 v = fl[LPAD(i * 256 + (int)brev(c, 8))];
                  const size_t o = ((size_t)g * 256 + d0 + i) * 512 + c;
                  B1[o] = (bf16_t)f2bf(v.x); B1[o + 256] = (bf16_t)f2bf(-v.y); B2[o] = (bf16_t)f2bf(v.x); B2[o + 256] = (bf16_t)f2bf(v.y); } }
            __syncthreads();
        }
    }
}

DV void h_gemm(const Params& p, unsigned char* lds_raw, _Float16* H, int pos0, int L) {
    const int tid = threadIdx.x, lane = tid & 63, wid = tid >> 6, G = gridDim.x;
    const bf16_t* H3 = (const bf16_t*)(p.ws + WS_H3) + (size_t)pos0 * 64; const bf16_t* W4T = (const bf16_t*)(p.ws + WS_W4T);
    unsigned char* wl = lds_raw + wid * 4608;
    const int ntg = L / 512, ntask = 128 * ntg;
    const int r = lane & 31, hh = lane >> 5;
    for (int task = blockIdx.x * 8 + wid; task < ntask; task += G * 8) {
        const int ct = task / ntg, tg = task % ntg;
        bf16x8 bf[4];
#pragma unroll
        for (int s = 0; s < 4; ++s) bf[s] = *(const bf16x8*)(W4T + (size_t)(ct * 32 + r) * 64 + 16 * s + 8 * hh);
        const int c = (ct * 32 + r) & 127;
        const float delta = -3.0701134573253946f + (-15.350567286626973f + 3.0701134573253946f) * ((float)c * (1.0f / 127.0f));
        const float dl = -fabsf(delta) * (1.0f / (float)(L - 1));
        bf16x8 afc[2][4];
#pragma unroll
        for (int w = 0; w < 2; ++w)
#pragma unroll
            for (int s = 0; s < 4; ++s) afc[w][s] = *(const bf16x8*)(H3 + (size_t)(tg * 512 + 32 * w + r) * 64 + 16 * s + 8 * hh);
        for (int tt = 0; tt < 8; ++tt) {
            const int t0 = tg * 512 + tt * 64;
            const int tn = tg * 512 + (tt < 7 ? tt + 1 : tt) * 64;
            bf16x8 afn[2][4];
#pragma unroll
            for (int w = 0; w < 2; ++w)
#pragma unroll
                for (int s = 0; s < 4; ++s) afn[w][s] = *(const bf16x8*)(H3 + (size_t)(tn + 32 * w + r) * 64 + 16 * s + 8 * hh);
#pragma unroll
            for (int w = 0; w < 2; ++w) {
                f32x16 acc;
#pragma unroll
                for (int i = 0; i < 16; ++i) acc[i] = 0.f;
#pragma unroll
                for (int s = 0; s < 4; ++s) acc = __builtin_amdgcn_mfma_f32_32x32x16_bf16(afc[w][s], bf[s], acc, 0, 0, 0);
#pragma unroll
                for (int g = 0; g < 4; ++g) {
                    const int tl = 32 * w + 8 * g + 4 * hh; float v[4];
#pragma unroll
                    for (int e = 0; e < 4; ++e) v[e] = acc[4 * g + e] * __expf(dl * (float)(t0 + tl + e)) * 256.0f;
                    u32x2 pk; pk.x = pack_h2(v[0], v[1]); pk.y = pack_h2(v[2], v[3]);
                    *(u32x2*)(wl + r * 144 + tl * 2) = pk;
                }
            }
            asm volatile("s_waitcnt lgkmcnt(0)" ::: "memory"); __builtin_amdgcn_wave_barrier();
#pragma unroll
            for (int q = 0; q < 4; ++q) {
                const int col = q * 8 + (lane >> 3), ch = lane & 7;
                const u32x4 v = *(const u32x4*)(wl + col * 144 + ch * 16);
                *(u32x4*)(H + (size_t)(ct * 32 + col) * L + t0 + ch * 8) = v;
            }
            asm volatile("s_waitcnt lgkmcnt(0)" ::: "memory"); __builtin_amdgcn_wave_barrier();
#pragma unroll
            for (int w = 0; w < 2; ++w)
#pragma unroll
                for (int s = 0; s < 4; ++s) afc[w][s] = afn[w][s];
        }
    }
    __syncthreads();
}
DV void wfold_gemm(const Params& p) {
    const int tid = threadIdx.x, lane = tid & 63, wid = tid >> 6, G = gridDim.x;
    const float* TF = (const float*)(p.ws + WS_TF); bf16_t* W1T = (bf16_t*)(p.ws + WS_W1T);
    const int r = lane & 31, hh = lane >> 5;
    for (int task = blockIdx.x * 8 + wid; task < 4096; task += G * 8) {
        const int kt = task & 63, dt = (task >> 6) & 15, g = task >> 10; const int part = dt >> 3, d0 = (dt & 7) * 32;
        const float* ap = TF + (((size_t)g * 2 + part) * 256 + hh) * 256 + d0 + r;
        const int k = kt * 32 + r;
        const float* bp = (const float*)(p.ws + WS_WFT) + (size_t)(g * 256 + hh) * DM + k;
        f32x16 acc;
#pragma unroll
        for (int i = 0; i < 16; ++i) acc[i] = 0.f;
#pragma unroll 8
        for (int c0 = 0; c0 < 256; c0 += 2) acc = __builtin_amdgcn_mfma_f32_32x32x2f32(ap[(size_t)c0 * 256], bp[(size_t)c0 * DM], acc, 0, 0, 0);
#pragma unroll
        for (int i = 0; i < 16; ++i) { const int row = (i & 3) + 8 * (i >> 2) + 4 * hh;
            W1T[(size_t)(3072 + part * 1024 + g * 256 + d0 + row) * DM + k] = (bf16_t)f2bf(acc[i]); }
    }
}

struct KfRaw { u32x4 a0, a1, b0, b1; _Float16 nxt; };
template <int NB> DV void kf_load(const Params& p, const _Float16* H, int task, int tid, KfRaw (&raw)[2]) {
    constexpr int L = 1 << NB, NSEQ = (NB == 14) ? 1 : 2;
#pragma unroll
    for (int u = 0; u < 2; ++u) {
        const int ch = tid + u * NTHR, q = ch / (L / 16), j = ch % (L / 16);
        const int row = task * NSEQ + q, o = row >> 10, c = row & 1023;
        const _Float16* hf = H + (size_t)((o * 2 + 0) * 1024 + c) * L; const _Float16* hb = H + (size_t)((o * 2 + 1) * 1024 + c) * L;
        raw[u].a0 = ldnt4(hf + 16 * j); raw[u].a1 = ldnt4(hf + 16 * j + 8);
        raw[u].b0 = ldnt4(hb + 16 * j); raw[u].b1 = ldnt4(hb + 16 * j + 8);
        raw[u].nxt = (16 * j + 16 < L) ? hb[16 * j + 16] : (_Float16)0.f;
    }
}
template <int NB> DV void kf_phase(const Params& p, float2* fl, const _Float16* H, uint2* KF) {
    constexpr int L = 1 << NB, NSEQ = (NB == 14) ? 1 : 2, SLOTS = L / 2;
    static_assert((NSEQ * (L / 16)) / NTHR == 2, "chunk geometry");
    const int tid = threadIdx.x, G = gridDim.x;
    KfRaw raw[2];
    if ((int)blockIdx.x < 2048 / NSEQ) kf_load<NB>(p, H, blockIdx.x, tid, raw);
    for (int task = blockIdx.x; task < 2048 / NSEQ; task += G) {
#pragma unroll
        for (int u = 0; u < 2; ++u) {
            const int ch = tid + u * NTHR, q = ch / (L / 16), j = ch % (L / 16);
            const int row = task * NSEQ + q, o = row >> 10, c = row & 1023;
            const float skip = p.in[I_SKIP][o * 1024 + c];
            const int base = q * L;
            const unsigned aw[8] = {raw[u].a0.x, raw[u].a0.y, raw[u].a0.z, raw[u].a0.w, raw[u].a1.x, raw[u].a1.y, raw[u].a1.z, raw[u].a1.w};
#pragma unroll
            for (int e = 0; e < 8; ++e) { float x = h_lo(aw[e]) * (1.0f / 256.0f), y = h_hi(aw[e]) * (1.0f / 256.0f); if (j == 0 && e == 0) x += skip; fl[LPAD(base + 8 * j + e)] = make_float2(x, y); }
            const unsigned bw[8] = {raw[u].b0.x, raw[u].b0.y, raw[u].b0.z, raw[u].b0.w, raw[u].b1.x, raw[u].b1.y, raw[u].b1.z, raw[u].b1.w};
            const float nxt = (float)raw[u].nxt * (1.0f / 256.0f);
#pragma unroll
            for (int a = 0; a < 8; ++a) { const float y = h_hi(bw[a]) * (1.0f / 256.0f); const float x = (a < 7) ? h_lo(bw[a + 1]) * (1.0f / 256.0f) : nxt;
                fl[LPAD(base + L - 8 * j - 1 - a)] = make_float2(x, y); }
        }
        __syncthreads();
        if (NB == 14) { fft_pass<5, 9, false>(fl, tid); __syncthreads(); fft_pass<5, 4, false>(fl, tid); __syncthreads(); }
        else { fft_pass<5, 8, false>(fl, tid); __syncthreads(); fft_pass<4, 4, false>(fl, tid); __syncthreads(); }
        kf_load<NB>(p, H, (task + G < 2048 / NSEQ) ? task + G : task, tid, raw);
        kf_mid<NB, NSEQ>(fl, tid, KF + (size_t)(task * NSEQ) * SLOTS, KF + (size_t)(task * NSEQ + NSEQ - 1) * SLOTS);
        __syncthreads();
    }
}

template <int NB> DV void fft_fwd(float2* fl, int tid) {
    if (NB == 14) { fft_pass<5, 9, false>(fl, tid); __syncthreads(); fft_pass<5, 4, false>(fl, tid); __syncthreads(); fft_pass<4, 0, false>(fl, tid); __syncthreads(); }
    else { fft_pass<5, 8, false>(fl, tid); __syncthreads(); fft_pass<4, 4, false>(fl, tid); __syncthreads(); fft_pass<4, 0, false>(fl, tid); __syncthreads(); }
}
template <int NB> DV void fft_inv(float2* fl, int tid) {
    if (NB == 14) { fft_pass<4, 0, true>(fl, tid); __syncthreads(); fft_pass<5, 4, true>(fl, tid); __syncthreads(); fft_pass<5, 9, true>(fl, tid); __syncthreads(); }
    else { fft_pass<4, 0, true>(fl, tid); __syncthreads(); fft_pass<4, 4, true>(fl, tid); __syncthreads(); fft_pass<5, 8, true>(fl, tid); __syncthreads(); }
}
template <int NB> DV void fft_fwd_zh(float2* fl, int tid) {
    if (NB == 14) { fft_pass<5, 9, false, true>(fl, tid); __syncthreads(); fft_pass<5, 4, false>(fl, tid); __syncthreads(); fft_pass<4, 0, false>(fl, tid); __syncthreads(); }
    else { fft_pass<5, 8, false, true>(fl, tid); __syncthreads(); fft_pass<4, 4, false>(fl, tid); __syncthreads(); fft_pass<4, 0, false>(fl, tid); __syncthreads(); }
}
template <int NB> DV void fft_inv_lh(float2* fl, int tid) {
    if (NB == 14) { fft_pass<4, 0, true>(fl, tid); __syncthreads(); fft_pass<5, 4, true>(fl, tid); __syncthreads(); fft_pass<5, 9, true, true>(fl, tid); __syncthreads(); }
    else { fft_pass<4, 0, true>(fl, tid); __syncthreads(); fft_pass<4, 4, true>(fl, tid); __syncthreads(); fft_pass<5, 8, true, true>(fl, tid); __syncthreads(); }
}

struct ScRaw { u32x4 a0, a1; unsigned short lo, hi; };
DV ScRaw sc_load(const bf16_t* rowp  , int tl, int L) {
    ScRaw r; r.a0 = ldnt4(rowp + tl); r.a1 = ldnt4(rowp + tl + 8);
    r.lo = tl > 0 ? rowp[tl - 1] : (unsigned short)0; r.hi = (tl + 16 < L) ? rowp[tl + 16] : (unsigned short)0; return r;
}
DV void sc_compute(const ScRaw& r, float w0, float w1, float w2, float b, float (&v)[16]) {
    const unsigned aw[8] = {r.a0.x, r.a0.y, r.a0.z, r.a0.w, r.a1.x, r.a1.y, r.a1.z, r.a1.w};
    float u[18];
    u[0] = bf2f(r.lo); u[17] = bf2f(r.hi);
#pragma unroll
    for (int e = 0; e < 8; ++e) { u[1 + 2 * e] = bf2f(aw[e] & 0xffffu); u[2 + 2 * e] = bf2f(aw[e] >> 16); }
#pragma unroll
    for (int e = 0; e < 16; ++e) v[e] = u[e] * w0 + u[e + 1] * w1 + u[e + 2] * w2 + b;
}
DV void short_conv16(const bf16_t* rowp, int tl, int L, float w0, float w1, float w2, float b, float (&v)[16]) { const ScRaw r = sc_load(rowp, tl, L); sc_compute(r, w0, w1, w2, b, v); }

template <int NB> DV void hyena_task(const Params& p, float2* fl, int c, const uint2* KF, int tok0) {
    constexpr int L = 1 << NB, NSEQ = (NB == 14) ? 1 : 2, SLOTS = L / 2;
    int tid = threadIdx.x; asm volatile("" : "+v"(tid));
    bf16_t* PT = (bf16_t*)(p.ws + WS_B);
    const float* cw = p.in[I_CONVW]; const float* cb = p.in[I_CONVB];
#pragma unroll
    for (int q = 0; q < NSEQ; ++q) {
        const bf16_t* rp = PT + (size_t)(2048 + c) * NTOK + tok0 + q * L; const int col = 2048 + c;
        const float w0 = cw[col], w1 = cw[3072 + col], w2 = cw[6144 + col], b = cb[col];
        for (int j = tid; j < L / 16; j += NTHR) {
            float v[16]; short_conv16(rp, 16 * j, L, w0, w1, w2, b, v);
#pragma unroll
            for (int e = 0; e < 8; ++e) fl[LPAD(q * L + 8 * j + e)] = make_float2(v[2 * e], v[2 * e + 1]);
        }
    }
    __syncthreads();
#pragma unroll 1
    for (int o = 0; o < 2; ++o) {
        if (NB == 14) { fft_pass<5, 9, false, true>(fl, tid); __syncthreads(); fft_pass<5, 4, false>(fl, tid); __syncthreads(); }
        else { fft_pass<5, 8, false, true>(fl, tid); __syncthreads(); fft_pass<4, 4, false>(fl, tid); __syncthreads(); }
        uint2 slots[16];
        kf_prefetch<NB, NSEQ>(KF + (size_t)(o * 1024 + c) * SLOTS, tid, slots);
        conv_mid<NB, NSEQ>(fl, tid, slots);
        __syncthreads();
        if (NB == 14) { fft_pass<5, 4, true>(fl, tid); __syncthreads(); }
        else { fft_pass<4, 4, true>(fl, tid); __syncthreads(); }
        asm volatile("" : "+v"(tid));
        const int col = o * 1024 + c;
        const float w0 = cw[col], w1 = cw[3072 + col], w2 = cw[6144 + col], b = cb[col];
        constexpr int NCH = (NSEQ * (L / 16)) / NTHR;
        static_assert(NCH == 2, "chunk geometry");
        ScRaw raw[NCH];
#pragma unroll
        for (int u = 0; u < NCH; ++u) { const int ch = tid + u * NTHR, q = ch / (L / 16), j = ch % (L / 16); raw[u] = sc_load(PT + (size_t)col * NTOK + tok0 + q * L, 16 * j, L); }
        if (NB == 14) fft_pass<5, 9, true, true>(fl, tid); else fft_pass<5, 8, true, true>(fl, tid);
        __syncthreads();
#pragma unroll
        for (int u = 0; u < NCH; ++u) {
            const int ch = tid + u * NTHR, q = ch / (L / 16), j = ch % (L / 16);
            bf16_t* op = PT + (size_t)(2048 + c) * NTOK + tok0 + q * L;
            float v[16]; sc_compute(raw[u], w0, w1, w2, b, v);
            float y[16];
#pragma unroll
            for (int e = 0; e < 8; ++e) { const float2 z = fl[LPAD(q * L + 8 * j + e)]; y[2 * e] = z.x * v[2 * e]; y[2 * e + 1] = z.y * v[2 * e + 1]; }
            if (o == 0) {
#pragma unroll
                for (int e = 0; e < 8; ++e) fl[LPAD(q * L + 8 * j + e)] = make_float2(y[2 * e], y[2 * e + 1]);
            } else {
                u32x4 w0v, w1v;
                w0v.x = pack_bf2(y[0], y[1]); w0v.y = pack_bf2(y[2], y[3]); w0v.z = pack_bf2(y[4], y[5]); w0v.w = pack_bf2(y[6], y[7]);
                w1v.x = pack_bf2(y[8], y[9]); w1v.y = pack_bf2(y[10], y[11]); w1v.z = pack_bf2(y[12], y[13]); w1v.w = pack_bf2(y[14], y[15]);
                *(u32x4*)(op + 16 * j) = w0v; *(u32x4*)(op + 16 * j + 8) = w1v;
            }
        }
        __syncthreads();
    }
}
template <int NB> DV void fnet_task(const Params& p, float2* fl, int j, int tok0) {
    constexpr int L = 1 << NB, NSEQ = (NB == 14) ? 1 : 2;
    int tid = threadIdx.x; asm volatile("" : "+v"(tid));
    bf16_t* PT = (bf16_t*)(p.ws + WS_B);
    const float bias = p.in[I_FNB][j]; const float scale = 1.0f / sqrtf((float)L * 256.0f);
#pragma unroll
    for (int q = 0; q < NSEQ; ++q) {
        const bf16_t* rr = PT + (size_t)(3072 + j) * NTOK + tok0 + q * L; const bf16_t* ri = PT + (size_t)(4096 + j) * NTOK + tok0 + q * L;
        for (int t = tid; t < L / 8; t += NTHR) {
            const u32x4 a = *(const u32x4*)(rr + 8 * t), b = *(const u32x4*)(ri + 8 * t);
            const unsigned aw[4] = {a.x, a.y, a.z, a.w}, bw[4] = {b.x, b.y, b.z, b.w};
#pragma unroll
            for (int e = 0; e < 4; ++e) {
                fl[LPAD(q * L + (int)brev(8 * t + 2 * e, NB))] = make_float2(bf2f(aw[e] & 0xffffu), -bf2f(bw[e] & 0xffffu));
                fl[LPAD(q * L + (int)brev(8 * t + 2 * e + 1, NB))] = make_float2(bf2f(aw[e] >> 16), -bf2f(bw[e] >> 16));
            }
        }
    }
    __syncthreads();
    fft_inv<NB>(fl, tid);
#pragma unroll
    for (int q = 0; q < NSEQ; ++q) {
        bf16_t* op = PT + (size_t)(3072 + j) * NTOK + tok0 + q * L;
        for (int t = tid; t < L / 8; t += NTHR) {
            float y[8];
#pragma unroll
            for (int e = 0; e < 8; ++e) y[e] = fl[LPAD(q * L + 8 * t + e)].x * scale + bias;
            u32x4 w; w.x = pack_bf2(y[0], y[1]); w.y = pack_bf2(y[2], y[3]); w.z = pack_bf2(y[4], y[5]); w.w = pack_bf2(y[6], y[7]);
            *(u32x4*)(op + 8 * t) = w;
        }
    }
    __syncthreads();
}


template <int NB> DV void fnet2_task(const Params& p, float2* fl, int pr, int tok0, int rowbase) {
    constexpr int L = 1 << NB, NSEQ = (NB == 14) ? 1 : 2, IB = NB - 10, HN = L / 2;
    int tid = threadIdx.x; asm volatile("" : "+v"(tid));
    bf16_t* PT = (bf16_t*)(p.ws + WS_B);
    bf16_t* UR = PT + (size_t)4096 * NTOK; bf16_t* UI = UR + (size_t)1024 * 16384;
    float* NYQ = (float*)(p.ws + WS_NYQ);
#pragma unroll
    for (int q = 0; q < NSEQ; ++q) {
        const bf16_t* ra = PT + (size_t)(3072 + 2 * pr) * NTOK + tok0 + q * L; const bf16_t* rb = ra + NTOK;
        for (int t = tid; t < L / 8; t += NTHR) {
            const u32x4 a = ldnt4(ra + 8 * t), b = ldnt4(rb + 8 * t);
            const unsigned aw[4] = {a.x, a.y, a.z, a.w}, bw[4] = {b.x, b.y, b.z, b.w};
#pragma unroll
            for (int e = 0; e < 4; ++e) {
                fl[LPAD(q * L + 8 * t + 2 * e)] = make_float2(bf2f(aw[e] & 0xffffu), bf2f(bw[e] & 0xffffu));
                fl[LPAD(q * L + 8 * t + 2 * e + 1)] = make_float2(bf2f(aw[e] >> 16), bf2f(bw[e] >> 16));
            }
        }
    }
    __syncthreads();
    if (NB == 14) { fft_pass<5, 9, false>(fl, tid); __syncthreads(); fft_pass<5, 4, false>(fl, tid); __syncthreads(); }
    else { fft_pass<5, 8, false>(fl, tid); __syncthreads(); fft_pass<4, 4, false>(fl, tid); __syncthreads(); }
    asm volatile("" : "+v"(tid));
    constexpr int NBB = NB - 4, TPS = NTHR / NSEQ;
    const int sq = tid / TPS, tp = tid % TPS, sbase = sq * L;
    const int Bv = tp ? (int)brev((unsigned)tp, NBB - 1) : (1 << (NBB - 1));
    v2f ua[16], ub[16];
    {
        const int bA = 2 * tp, bB = tp ? (int)brev((unsigned)((1 << NBB) - (int)brev((unsigned)bA, NBB)), NBB) : 1;
        const v2f* pA = (const v2f*)fl + LPAD(sbase + 16 * bA); const v2f* pB = (const v2f*)fl + LPAD(sbase + 16 * bB);
        v2f xa[16], xb[16];
#pragma unroll
        for (int e = 0; e < 16; ++e) { xa[e] = pA[e]; xb[e] = pB[e]; }
        dif_regs<4>(xa); dif_regs<4>(xb);
#define FSEP(i, P, Q) do { ua[i] = (v2f){0.5f * ((P).x + (Q).x), 0.5f * ((P).y - (Q).y)}; ub[i] = (v2f){0.5f * ((P).y + (Q).y), -0.5f * ((P).x - (Q).x)}; } while (0)
        if (tp != 0) {
#pragma unroll
            for (int e = 0; e < 16; ++e) { if (brev_c(e, 4) < 8) FSEP(e, xa[e], xb[15 - e]); else FSEP(e, xb[15 - e], xa[e]); }
        } else {
#pragma unroll
            for (int e = 0; e < 8; ++e) { if (brev_c(e, 4) < 8) FSEP(e, xb[e], xb[15 - e]); else FSEP(e, xb[15 - e], xb[e]); }
            ua[8] = (v2f){xa[0].x, 0.f}; ub[8] = (v2f){xa[0].y, 0.f};
            { const int seq = (NB == 14) ? 0 : 1 + sq; NYQ[seq * 1024 + 2 * pr] = xa[1].x; NYQ[seq * 1024 + 2 * pr + 1] = xa[1].y; }
#pragma unroll
            for (int E = 1; E < 8; ++E) FSEP(8 + E, xa[brev_c(E, 4)], xa[brev_c(16 - E, 4)]);
        }
#undef FSEP
    }
    __syncthreads();
#pragma unroll
    for (int i = 0; i < 16; ++i) {
        int kk;
        if (tp != 0 || i < 8) { const int E = brev_c(i, 4), k = (E << NBB) | Bv; kk = E < 8 ? k : L - k; }
        else kk = (i - 8) << NBB;
        ((v2f*)fl)[LPAD(sbase + kk)] = ua[i]; ((v2f*)fl)[LPAD(sbase + HN + kk)] = ub[i];
    }
    __syncthreads();
#pragma unroll
    for (int q = 0; q < NSEQ; ++q)
#pragma unroll
        for (int ch = 0; ch < 2; ++ch) {
            const size_t ro = (size_t)(2 * pr + ch) * 16384 + rowbase + q * HN;
            for (int t = tid; t < HN / 8; t += NTHR) {
                float2 z[8];
#pragma unroll
                for (int e = 0; e < 8; ++e) z[e] = fl[LPAD(q * L + ch * HN + 8 * t + e)];
                u32x4 wr_, wi_;
                wr_.x = pack_bf2(z[0].x, z[1].x); wr_.y = pack_bf2(z[2].x, z[3].x); wr_.z = pack_bf2(z[4].x, z[5].x); wr_.w = pack_bf2(z[6].x, z[7].x);
                wi_.x = pack_bf2(z[0].y, z[1].y); wi_.y = pack_bf2(z[2].y, z[3].y); wi_.z = pack_bf2(z[4].y, z[5].y); wi_.w = pack_bf2(z[6].y, z[7].y);
                *(u32x4*)(UR + ro + 8 * t) = wr_; *(u32x4*)(UI + ro + 8 * t) = wi_;
            }
        }
    __syncthreads();
}
DV void utrans_phase(const Params& p, unsigned char* lds_raw) {
    const int tid = threadIdx.x, lane = tid & 63, wid = tid >> 6, G = gridDim.x;
    unsigned* tl = (unsigned*)lds_raw;
    const bf16_t* PT = (const bf16_t*)(p.ws + WS_B);
    const bf16_t* UR = PT + (size_t)4096 * NTOK; const bf16_t* UI = UR + (size_t)1024 * 16384;
    bf16_t* AG = (bf16_t*)(p.ws + WS_B) + (size_t)1024 * NTOK;
    for (int item = blockIdx.x; item < 512; item += G) {
        const int plane = item & 1, r0 = (item >> 1) * 64; const bf16_t* src = plane ? UI : UR;
#pragma unroll
        for (int it = 0; it < 8; ++it) {
            const int id = it * NTHR + tid, q = id & 7, cp = id >> 3;
            const bf16_t* ra = src + (size_t)(2 * cp) * 16384 + r0 + 8 * q;
            const u32x4 a = ldnt4(ra), b = ldnt4(ra + 16384);
            const unsigned aw[4] = {a.x, a.y, a.z, a.w}, bw[4] = {b.x, b.y, b.z, b.w};
            const int pc = cp ^ (q << 2);
#pragma unroll
            for (int e = 0; e < 4; ++e) {
                tl[(8 * q + 2 * e) * 512 + pc] = (aw[e] & 0xffffu) | (bw[e] << 16);
                tl[(8 * q + 2 * e + 1) * 512 + pc] = (aw[e] >> 16) | (bw[e] & 0xffff0000u);
            }
        }
        __syncthreads();
#pragma unroll
        for (int tk = 0; tk < 8; ++tk) {
            const int tok = wid * 8 + tk;
#pragma unroll
            for (int j = 0; j < 2; ++j) {
                const int g4 = lane + 64 * j, g = g4 >> 5, cl = (8 * g4) & 255;
                const u32x4 d = *(const u32x4*)(tl + tok * 512 + 4 * (g4 ^ wid));
                *(u32x4*)(AG + ((size_t)g * 16384 + r0 + tok) * 512 + plane * 256 + cl) = d;
            }
        }
        __syncthreads();
    }
}
DV void nyquist_fix(const Params& p) {
    const float* NYQ = (const float*)(p.ws + WS_NYQ); const float* TF = (const float*)(p.ws + WS_TF);
    bf16_t* YG = (bf16_t*)(p.ws + WS_B);
    for (int o = blockIdx.x * NTHR + threadIdx.x; o < 3072; o += gridDim.x * NTHR) {
        const int seq = o >> 10, col = o & 1023, g = col >> 8, d = col & 255;
        float acc = 0.f;
        for (int c = 0; c < 256; ++c) acc += NYQ[seq * 1024 + g * 256 + c] * TF[(((size_t)g * 2 + 0) * 256 + c) * 256 + d];
        const int L = seq == 0 ? LP : LS, tok0 = seq == 0 ? 0 : LP + (seq - 1) * LS;
        const float scale = seq == 0 ? (1.0f / 2048.0f) : 0.00069053396600248786f;
        YG[(size_t)(tok0 + L / 2) * 1024 + col] = (bf16_t)f2bf(acc * scale + p.in[I_FNB][col]);
    }
}

DV void gate_phase(const Params& p, unsigned char* lds_raw) {
    const int tid = threadIdx.x, lane = tid & 63, wid = tid >> 6, G = gridDim.x;
    unsigned* tl = (unsigned*)lds_raw;
    const bf16_t* PT = (const bf16_t*)(p.ws + WS_B);
    const unsigned* ZT = (const unsigned*)((const unsigned char*)p.out + OUT_ZT); unsigned* T = (unsigned*)(p.ws + WS_A);
    for (int item = blockIdx.x; item < 1024; item += G) {
        const int half = item & 1, m0 = (item >> 1) * 64;
        const unsigned* YG = (const unsigned*)(p.ws + WS_B);
        u32x4 zt[8][2];
#pragma unroll
        for (int tk = 0; tk < 8; ++tk)
#pragma unroll
            for (int j = 0; j < 2; ++j) zt[tk][j] = ldnt4(ZT + (size_t)(m0 + wid * 8 + tk) * 1024 + half * 512 + 4 * (lane + 64 * j));
        if (half == 0)
#pragma unroll
        for (int it = 0; it < 8; ++it) {
            const int id = it * NTHR + tid, q = id & 7, cp = id >> 3;
            const bf16_t* ra = PT + (size_t)(2048 + half * 1024 + 2 * cp) * NTOK + m0 + 8 * q;
            const u32x4 a = ldnt4(ra), b = ldnt4(ra + NTOK);
            const unsigned aw[4] = {a.x, a.y, a.z, a.w}, bw[4] = {b.x, b.y, b.z, b.w};
            const int pc = cp ^ (q << 2);
#pragma unroll
            for (int e = 0; e < 4; ++e) {
                tl[(8 * q + 2 * e) * 512 + pc] = (aw[e] & 0xffffu) | (bw[e] << 16);
                tl[(8 * q + 2 * e + 1) * 512 + pc] = (aw[e] >> 16) | (bw[e] & 0xffff0000u);
            }
        }
        __syncthreads();
#pragma unroll
        for (int tk = 0; tk < 8; ++tk) {
            const int tok = wid * 8 + tk; const size_t mrow = (size_t)(m0 + tok) * 1024 + half * 512;
            float pr[16]; float q = 0.f;
#pragma unroll
            for (int j = 0; j < 2; ++j) {
                const int g4 = lane + 64 * j;
                const u32x4 d = half ? ldnt4(YG + (size_t)(m0 + tok) * 512 + 4 * g4) : *(const u32x4*)(tl + tok * 512 + 4 * (g4 ^ wid)), z = zt[tk][j];
                const unsigned dw[4] = {d.x, d.y, d.z, d.w}, zw[4] = {z.x, z.y, z.z, z.w};
#pragma unroll
                for (int e = 0; e < 4; ++e) { const float v0 = bf2f(dw[e] & 0xffffu) * pg8::silu_f(bf2f(zw[e] & 0xffffu)), v1 = bf2f(dw[e] >> 16) * pg8::silu_f(bf2f(zw[e] >> 16));
                    pr[8 * j + 2 * e] = v0; pr[8 * j + 2 * e + 1] = v1; q += v0 * v0 + v1 * v1; }
            }
            q = wave_sum(q);
            const float rs = rsqrtf(q * (1.0f / 1024.0f) + 1e-6f);
#pragma unroll
            for (int j = 0; j < 2; ++j) {
                u32x4 o; o.x = pack_bf2(pr[8 * j] * rs, pr[8 * j + 1] * rs); o.y = pack_bf2(pr[8 * j + 2] * rs, pr[8 * j + 3] * rs);
                o.z = pack_bf2(pr[8 * j + 4] * rs, pr[8 * j + 5] * rs); o.w = pack_bf2(pr[8 * j + 6] * rs, pr[8 * j + 7] * rs);
                *(u32x4*)(T + mrow + 4 * (lane + 64 * j)) = o;
            }
        }
        __syncthreads();
    }
}
DV void final_phase(const Params& p) {
    const int tid = threadIdx.x, lane = tid & 63, wid = tid >> 6, G = gridDim.x;
    const bf16_t* Y = (const bf16_t*)(p.ws + WS_B); const float* fn = p.in[I_FNORM];
    for (int row0 = blockIdx.x * 8 + wid; row0 < NTOK; row0 += 2 * G * 8) {
        u32x4 yv[2][4]; f32x4 xa[2][4], xb[2][4];
#pragma unroll
        for (int u = 0; u < 2; ++u) { const int row = (row0 + u * G * 8 < NTOK) ? row0 + u * G * 8 : row0;
            const float* xr = row < LP ? p.in[I_XP] + (size_t)row * DM : p.in[I_XS] + (size_t)(row - LP) * DM;
#pragma unroll
            for (int j = 0; j < 4; ++j) { const int c = j * 512 + lane * 8; yv[u][j] = __builtin_nontemporal_load((const u32x4*)(Y + (size_t)row * DM + c)); xa[u][j] = __builtin_nontemporal_load((const f32x4*)(xr + c)); xb[u][j] = __builtin_nontemporal_load((const f32x4*)(xr + c + 4)); } }
#pragma unroll
        for (int u = 0; u < 2; ++u) { const int row = row0 + u * G * 8; if (row >= NTOK) continue;
            float r[32]; float q = 0.f;
#pragma unroll
            for (int j = 0; j < 4; ++j) { const u32x4 y = yv[u][j]; const f32x4 a = xa[u][j], b = xb[u][j];
                r[8 * j + 0] = a[0] + bf2f(y.x & 0xffffu); r[8 * j + 1] = a[1] + bf2f(y.x >> 16); r[8 * j + 2] = a[2] + bf2f(y.y & 0xffffu); r[8 * j + 3] = a[3] + bf2f(y.y >> 16);
                r[8 * j + 4] = b[0] + bf2f(y.z & 0xffffu); r[8 * j + 5] = b[1] + bf2f(y.z >> 16); r[8 * j + 6] = b[2] + bf2f(y.w & 0xffffu); r[8 * j + 7] = b[3] + bf2f(y.w >> 16);
#pragma unroll
                for (int e = 0; e < 8; ++e) q += r[8 * j + e] * r[8 * j + e]; }
            q = wave_sum(q);
            const float s = rsqrtf(q * (1.0f / DM) + 1e-6f);
            float* o = p.out + (size_t)row * DM;
#pragma unroll
            for (int j = 0; j < 4; ++j) {
                const int c = j * 512 + lane * 8; const f32x4 g0 = *(const f32x4*)(fn + c), g1 = *(const f32x4*)(fn + c + 4);
                f32x4 v0, v1;
#pragma unroll
                for (int e = 0; e < 4; ++e) { v0[e] = r[8 * j + e] * s * g0[e]; v1[e] = r[8 * j + 4 + e] * s * g1[e]; }
                __builtin_nontemporal_store(v0, (f32x4*)(o + c)); __builtin_nontemporal_store(v1, (f32x4*)(o + c + 4)); } }
    }
}

DV void mix_phase(const Params& p, unsigned char* lds_raw) {
    unsigned char* ws = p.ws; const int G = gridDim.x, bx = blockIdx.x;
    const bf16_t* AG = (const bf16_t*)(ws + WS_B) + (size_t)1024 * NTOK; const bf16_t* B1 = (const bf16_t*)(ws + WS_BMIX); const bf16_t* B2 = B1 + 4 * 256 * 512;
#pragma unroll 1
    for (int j = 0; j < 8; ++j) { const int g = j >> 1, mir = j & 1;
        pg8::Gemm gm{AG + (size_t)g * 16384 * 512, (mir ? B2 : B1) + (size_t)g * 256 * 512, 16384, 256, 512};
        pg8::StaticOrder S; S.init(16384, 256, G, (bx + 8 * G - 64 * j) % G);
        pg8::EpiMix E{(bf16_t*)(ws + WS_B), p.in[I_FNB], g, mir};
        pg8::gemm_phase<pg8::EpiMix>((LAS unsigned char*)lds_raw, gm, S, E); }
    nyquist_fix(p);
}

__global__ void __launch_bounds__(NTHR, 2) mega(Params p) {
    extern __shared__ __attribute__((aligned(16))) unsigned char lds_raw[];
    float2* fl = (float2*)lds_raw;
    const int lo = p.ph_lo, hi = p.ph_hi, G = gridDim.x, bx = blockIdx.x;
    unsigned char* ws = p.ws;
#ifndef PH_MASK
#define PH_MASK 0x7ff
#endif
#define IN(k) (((PH_MASK >> (k)) & 1) && lo <= (k) && (k) < hi)
#define SEAM(k) do { if (IN(k) && IN((k) + 1)) xcd_barrier(bar); } while (0)
    XcdBarrier bar; bar.bar = (unsigned*)(ws + WS_BAR); bar.x = 0; bar.st = (volatile LAS unsigned*)((LAS unsigned char*)lds_raw + (LDS_BYTES - 16));
    if (hi - lo > 1) {
        if (threadIdx.x < 2) bar.st[threadIdx.x] = 0u;
        __syncthreads();
        bar = xcd_barrier_post((unsigned*)(ws + WS_BAR), bar.st);
    }
    if (lo < 0) cg::this_grid().sync();
#define PHASE(k, ...) do { if (IN(k)) { __VA_ARGS__ } SEAM(k); } while (0)
    PHASE(0, phase0(p, lds_raw););
    PHASE(1, h_gemm(p, lds_raw, (_Float16*)(ws + WS_B), 0, LP); h_gemm(p, lds_raw, (_Float16*)(ws + WS_B + (size_t)4096 * NTOK * 2), LP, LS););
    PHASE(2, kf_phase<14>(p, fl, (const _Float16*)(ws + WS_B), (uint2*)((unsigned char*)p.out + OUT_KFP)););
    PHASE(3,
        const bf16_t* XB = (const bf16_t*)(ws + WS_A); const bf16_t* W1T = (const bf16_t*)(ws + WS_W1T);
        { pg8::Gemm g{W1T, XB, 4096, NTOK, DM}; pg8::StaticOrder S; S.init(4096, NTOK, G, bx); pg8::EpiY E{(bf16_t*)(ws + WS_B), NTOK};
          pg8::gemm_phase<pg8::EpiY>((LAS unsigned char*)lds_raw, g, S, E); }
        { pg8::Gemm g{XB, W1T + (size_t)5120 * DM, NTOK, 2048, DM}; pg8::StaticOrder S; S.init(NTOK, 2048, G, bx); pg8::EpiY E{(bf16_t*)((unsigned char*)p.out + OUT_ZT), 2048};
          pg8::gemm_phase<pg8::EpiY>((LAS unsigned char*)lds_raw, g, S, E); }
    );
    PHASE(4, kf_phase<13>(p, fl, (const _Float16*)(ws + WS_B + (size_t)4096 * NTOK * 2), (uint2*)(ws + WS_A + 64 * MiB)););
    PHASE(5,
        const uint2* KFP = (const uint2*)((unsigned char*)p.out + OUT_KFP); const uint2* KFS = (const uint2*)(ws + WS_A + 64 * MiB);
        for (int c = bx; c < 1024; c += G) { hyena_task<14>(p, fl, c, KFP, 0); hyena_task<13>(p, fl, c, KFS, LP); }
        for (int j = bx; j < 512; j += G) { fnet2_task<14>(p, fl, j, 0, 0); fnet2_task<13>(p, fl, j, LP, 8192); }
    );
    PHASE(6, utrans_phase(p, lds_raw););
    PHASE(7, mix_phase(p, lds_raw););
    PHASE(8, gate_phase(p, lds_raw););
    PHASE(9,
        pg8::Gemm g{(const bf16_t*)(ws + WS_A), (const bf16_t*)(ws + WS_WOT), NTOK, DM, DM}; pg8::StaticOrder S; S.init(NTOK, DM, G, bx);
        pg8::EpiY E{(bf16_t*)(ws + WS_B), DM};
        pg8::gemm_phase<pg8::EpiY>((LAS unsigned char*)lds_raw, g, S, E);
    );
    PHASE(10, final_phase(p););
#undef PHASE
#undef IN
#undef SEAM
}

constexpr int N_PHASES = 11;
#ifndef HOST_TEST
extern "C" void kernel_launch(void* const* d_in, const int* in_sizes, int n_in, void* d_out, int out_size, void* d_ws, size_t ws_size, hipStream_t stream) {
    static int grid = 0;
    if (grid == 0) {
        if (n_in != 21 || out_size != NTOK * DM || ws_size < WS_END) { fprintf(stderr, "kernel_launch: unexpected shapes (n_in %d out %d ws %zu)\n", n_in, out_size, ws_size); grid = -1; return; }
        int dev = 0, cus = 0, per_cu = 0;
        (void)hipGetDevice(&dev); (void)hipDeviceGetAttribute(&cus, hipDeviceAttributeMultiprocessorCount, dev);
        if (hipFuncSetAttribute((const void*)mega, hipFuncAttributeMaxDynamicSharedMemorySize, LDS_BYTES) != hipSuccess) { fprintf(stderr, "kernel_launch: hipFuncSetAttribute failed\n"); grid = -1; return; }
        if (hipOccupancyMaxActiveBlocksPerMultiprocessor(&per_cu, (const void*)mega, NTHR, LDS_BYTES) != hipSuccess || per_cu < 1) { fprintf(stderr, "kernel_launch: occupancy query says %d\n", per_cu); per_cu = 1; }
        (void)hipGetLastError();
        grid = cus;
    }
    if (grid < 0) return;
    Params p{};
    for (int i = 0; i < 21; ++i) p.in[i] = (const float*)d_in[i];
    p.out = (float*)d_out; p.ws = (unsigned char*)d_ws;
#if N_LAUNCH_MODE == 1
    p.ph_lo = 0; p.ph_hi = N_PHASES;
    if (hipMemsetAsync((unsigned char*)d_ws + WS_BAR, 0, XCD_BAR_WORDS * 4, stream) != hipSuccess) { fprintf(stderr, "kernel_launch: memset of the barrier words failed\n"); return; }
    void* args[] = {&p};
    hipError_t e = hipLaunchCooperativeKernel((const void*)mega, dim3(grid), dim3(NTHR), args, LDS_BYTES, stream);
    if (e != hipSuccess) fprintf(stderr, "cooperative launch failed: %s (grid %d)\n", hipGetErrorString(e), grid);
#else
    for (int k = 0; k < N_PHASES; ++k) for (int r = 0; r < (k == PROBE_REP ? 2 : 1); ++r) { p.ph_lo = k; p.ph_hi = k + 1; hipLaunchKernelGGL(mega, dim3(grid), dim3(NTHR), LDS_BYTES, stream, p); }
#endif
}
#endif
```
